# Optimizing an MI355X kernel written in HIP

```python
import jax, jax.numpy as jnp
from jax import lax
import numpy as np

D_MODEL = 2048
BATCH = 8
SEQ = 2048
DEPTH = 1

GRID_W = 64
MIX_W = D_MODEL
RWKV_W = MIX_W // 2
ATTN_W = MIX_W - RWKV_W
HEAD_DIM = 64
RWKV_HEADS = RWKV_W // HEAD_DIM
ATTN_Q_HEADS = ATTN_W // HEAD_DIM
ATTN_KV_HEADS = 4
KV_GROUPS = ATTN_Q_HEADS // ATTN_KV_HEADS
KV_W = ATTN_KV_HEADS * HEAD_DIM
DECAY_LORA = 96
AAA_LORA = 96
GATE_LORA = 256
GN_EPS = 64e-5
ROPE_THETA = 10000.0
ROPE_AXIS_DIM = HEAD_DIM // 2
Q_BLOCK = 128
NORM_EPS = 1e-6
PEER_HEADS = 8
PEER_KEY_DIM = 256
PEER_HALF = PEER_KEY_DIM // 2
N_KEYS = 128
N_EXPERTS = N_KEYS * N_KEYS
PEER_TOPK = 16
PEER_CHUNK = 128

RWKV_SPLITS = (RWKV_W, 2 * RWKV_W, 3 * RWKV_W,
               3 * RWKV_W + DECAY_LORA, 3 * RWKV_W + 2 * DECAY_LORA,
               3 * RWKV_W + 2 * DECAY_LORA + AAA_LORA, 3 * RWKV_W + 2 * DECAY_LORA + 2 * AAA_LORA)
RWKV_COLS = 3 * RWKV_W + 2 * DECAY_LORA + 2 * AAA_LORA + GATE_LORA
IN_SPLITS = (RWKV_COLS, RWKV_COLS + ATTN_W, RWKV_COLS + ATTN_W + KV_W)
IN_COLS = RWKV_COLS + ATTN_W + 2 * KV_W

kernel_name = "hybrid_rwkv7_axialgqa_peer_encoder"


def rmsnorm(x, w):
    xf = x.astype(jnp.float32)
    y = xf * lax.rsqrt(jnp.mean(xf * xf, axis=-1, keepdims=True) + NORM_EPS)
    return (y * w.astype(jnp.float32)).astype(x.dtype)


def centred_shift(z, mu_prev, mu_next):
    zp = jnp.pad(z[:, :-1], ((0, 0), (1, 0), (0, 0)))
    zn = jnp.pad(z[:, 1:], ((0, 0), (0, 1), (0, 0)))
    return z + mu_prev * (zp - z) + mu_next * (zn - z)


def rwkv7_bidir(z, mu_prev, mu_next, w0, w2, a0, a2, g2, k_k, k_a, r_k, lnx_w, lnx_b):
    B, S, _ = z.shape
    H, N = RWKV_HEADS, HEAD_DIM
    f32 = jnp.float32
    z = centred_shift(z.astype(f32), mu_prev.astype(f32), mu_next.astype(f32))
    r, k, v, wl_f, wl_b, al_f, al_b, gl = jnp.split(z, RWKV_SPLITS, axis=-1)
    wl = jnp.stack([wl_f, wl_b])
    al = jnp.stack([al_f, al_b])
    w_log = -jax.nn.softplus(-(w0.astype(f32)[:, None, None, :]
                               + jnp.einsum('nbsl,nlc->nbsc', jnp.tanh(wl), w2.astype(f32)))) - 0.5
    decay = jnp.exp(-jnp.exp(w_log))
    a = jax.nn.sigmoid(a0.astype(f32)[:, None, None, :]
                       + jnp.einsum('nbsl,nlc->nbsc', al, a2.astype(f32)))
    g = jax.nn.sigmoid(gl) @ g2.astype(f32)
    kk = (k * k_k.astype(f32)).reshape(B, S, H, N)
    kk = kk / jnp.maximum(jnp.sqrt(jnp.sum(kk * kk, axis=-1, keepdims=True)), 1e-12)
    kk = kk.reshape(B, S, RWKV_W)
    k_dir = k[None] * (1.0 + (a - 1.0) * k_a.astype(f32))
    ka = kk[None] * a

    def dir_seq(arr):
        arr = jnp.stack([arr[0], arr[1][:, ::-1]])
        return jnp.moveaxis(arr.reshape(2, B, S, H, N), 2, 0)

    xs = (dir_seq(jnp.stack([r, r])), dir_seq(decay), dir_seq(k_dir),
          dir_seq(jnp.stack([v, v])), dir_seq(jnp.stack([kk, kk])), dir_seq(ka))

    def step(state, inp):
        r_t, w_t, k_t, v_t, kk_t, ka_t = inp
        sa = jnp.einsum('dbhij,dbhj->dbhi', state, -kk_t)
        state = (state * w_t[..., None, :] + sa[..., :, None] * ka_t[..., None, :]
                 + v_t[..., :, None] * k_t[..., None, :])
        y = jnp.einsum('dbhij,dbhj->dbhi', state, r_t)
        return state, y

    state0 = jnp.zeros((2, B, H, N, N), f32)
    _, ys = lax.scan(step, state0, xs)
    ys = jnp.moveaxis(ys, 0, 2)
    y = ys[0] + ys[1][:, ::-1]
    mu = jnp.mean(y, axis=-1, keepdims=True)
    var = jnp.mean(jnp.square(y - mu), axis=-1, keepdims=True)
    y = ((y - mu) * lax.rsqrt(var + GN_EPS)).reshape(B, S, RWKV_W)
    y = y * lnx_w.astype(f32) + lnx_b.astype(f32)
    k_mean = jnp.mean(k_dir, axis=0).reshape(B, S, H, N)
    bonus = jnp.sum(r.reshape(B, S, H, N) * k_mean * r_k.astype(f32), axis=-1, keepdims=True) \
        * v.reshape(B, S, H, N)
    return (y + bonus.reshape(B, S, RWKV_W)) * g


def axial_rope_tables(S):
    rows_count = S // GRID_W
    rows = jnp.repeat(jnp.arange(rows_count), GRID_W).astype(jnp.float32)
    cols = jnp.tile(jnp.arange(GRID_W), rows_count).astype(jnp.float32)
    inv = ROPE_THETA ** (-jnp.arange(0, ROPE_AXIS_DIM, 2, dtype=jnp.float32) / ROPE_AXIS_DIM)
    ang_r = rows[:, None] * inv[None]
    ang_c = cols[:, None] * inv[None]
    return jnp.cos(ang_r), jnp.sin(ang_r), jnp.cos(ang_c), jnp.sin(ang_c)


def rope_rotate(x, cos, sin):
    x1, x2 = jnp.split(x, 2, axis=-1)
    c, s = cos[None, :, None, :], sin[None, :, None, :]
    return jnp.concatenate([x1 * c - x2 * s, x2 * c + x1 * s], axis=-1)


def axial_rope(x, tabs):
    cr, sr, cc, sc = tabs
    xr, xc = x[..., :ROPE_AXIS_DIM], x[..., ROPE_AXIS_DIM:]
    return jnp.concatenate([rope_rotate(xr, cr, sr), rope_rotate(xc, cc, sc)], axis=-1)


def axial_gqa(q, k, v, q_norm_w, k_norm_w):
    B, S, _ = q.shape
    dt = q.dtype
    q = q.reshape(B, S, ATTN_Q_HEADS, HEAD_DIM)
    k = k.reshape(B, S, ATTN_KV_HEADS, HEAD_DIM)
    v = v.reshape(B, S, ATTN_KV_HEADS, HEAD_DIM)
    tabs = axial_rope_tables(S)
    q = axial_rope(rmsnorm(q, q_norm_w).astype(jnp.float32), tabs) * (HEAD_DIM ** -0.5)
    k = axial_rope(rmsnorm(k, k_norm_w).astype(jnp.float32), tabs)
    q = q.astype(dt).reshape(B, S // Q_BLOCK, Q_BLOCK, ATTN_KV_HEADS, KV_GROUPS, HEAD_DIM)
    q = jnp.moveaxis(q, 1, 0)
    k = k.astype(dt)

    def block(q_blk):
        s = jnp.einsum('bqkgd,bskd->bkgqs', q_blk, k).astype(jnp.float32)
        p = jax.nn.softmax(s, axis=-1)
        return jnp.einsum('bkgqs,bskd->bqkgd', p.astype(v.dtype), v)

    o = lax.map(block, q)
    return jnp.moveaxis(o, 0, 1).reshape(B, S, ATTN_W)


def peer_ffn(h, w_pq, sub_keys, u_tab, v_tab):
    B, S, Dm = h.shape
    T = B * S
    hf = h.reshape(T, Dm)
    q = (hf @ w_pq).reshape(T, PEER_HEADS, 2, PEER_HALF)
    s = jnp.einsum('thpc,hpnc->thpn', q, sub_keys).astype(jnp.float32)
    s1, i1 = lax.top_k(s[:, :, 0], PEER_TOPK)
    s2, i2 = lax.top_k(s[:, :, 1], PEER_TOPK)
    cand = (s1[..., :, None] + s2[..., None, :]).reshape(T, PEER_HEADS, PEER_TOPK * PEER_TOPK)
    best, ci = lax.top_k(cand, PEER_TOPK)
    e1 = jnp.take_along_axis(i1, ci // PEER_TOPK, axis=-1)
    e2 = jnp.take_along_axis(i2, ci % PEER_TOPK, axis=-1)
    expert = (e1 * N_KEYS + e2).reshape(T, PEER_HEADS * PEER_TOPK)
    gate = jax.nn.softmax(best, axis=-1).reshape(T, PEER_HEADS * PEER_TOPK).astype(h.dtype)
    nc = T // PEER_CHUNK

    def chunk(args):
        hc, ec, gc = args
        u = jnp.take(u_tab, ec, axis=0)
        act = jax.nn.gelu(jnp.einsum('cd,ckd->ck', hc, u), approximate=False) * gc
        vv = jnp.take(v_tab, ec, axis=0)
        return jnp.einsum('ck,ckd->cd', act, vv)

    out = lax.map(chunk, (hf.reshape(nc, PEER_CHUNK, Dm),
                          expert.reshape(nc, PEER_CHUNK, -1),
                          gate.reshape(nc, PEER_CHUNK, -1)))
    return out.reshape(B, S, Dm)


def setup_inputs(seed: int = 0) -> dict:
    key = jax.random.key(seed)
    ks = jax.random.split(key, 32)
    L, D, C = DEPTH, D_MODEL, RWKV_W
    nrm = lambda k, shape, scale: jax.random.normal(k, shape, jnp.float32) * scale
    return {
        "x": nrm(ks[0], (BATCH, SEQ, D), 1.0),
        "w_in": nrm(ks[1], (L, D, IN_COLS), D ** -0.5),
        "mu_prev": jax.random.uniform(ks[2], (L, RWKV_COLS), jnp.float32, 0.0, 0.5),
        "mu_next": jax.random.uniform(ks[3], (L, RWKV_COLS), jnp.float32, 0.0, 0.5),
        "w0": jax.random.uniform(ks[4], (L, 2, C), jnp.float32, -6.0, -1.0),
        "w2": nrm(ks[5], (L, 2, DECAY_LORA, C), 0.5 * DECAY_LORA ** -0.5),
        "a0": nrm(ks[6], (L, 2, C), 0.1),
        "a2": nrm(ks[7], (L, 2, AAA_LORA, C), AAA_LORA ** -0.5),
        "g2": nrm(ks[8], (L, GATE_LORA, C), GATE_LORA ** -0.5),
        "k_k": 0.85 + nrm(ks[9], (L, C), 0.05),
        "k_a": 1.0 + nrm(ks[10], (L, C), 0.05),
        "r_k": nrm(ks[11], (L, RWKV_HEADS, HEAD_DIM), 0.1),
        "lnx_w": 1.0 + nrm(ks[12], (L, C), 0.02),
        "lnx_b": nrm(ks[13], (L, C), 0.01),
        "q_norm_w": 1.0 + nrm(ks[14], (L, HEAD_DIM), 0.02),
        "k_norm_w": 1.0 + nrm(ks[15], (L, HEAD_DIM), 0.02),
        "w_out": nrm(ks[16], (L, MIX_W, D), MIX_W ** -0.5),
        "norm1_w": 1.0 + nrm(ks[17], (L, D), 0.02),
        "norm2_w": 1.0 + nrm(ks[18], (L, D), 0.02),
        "w_pq": nrm(ks[19], (L, D, PEER_HEADS * PEER_KEY_DIM), D ** -0.5),
        "sub_keys": nrm(ks[20], (L, PEER_HEADS, 2, N_KEYS, PEER_HALF), PEER_HALF ** -0.5),
        "u_tab": nrm(ks[21], (L, N_EXPERTS, D), D ** -0.5),
        "v_tab": nrm(ks[22], (L, N_EXPERTS, D), 0.1),
        "normf_w": 1.0 + nrm(ks[23], (D,), 0.02),
    }


def reference(x, w_in, mu_prev, mu_next, w0, w2, a0, a2, g2, k_k, k_a, r_k, lnx_w, lnx_b,
              q_norm_w, k_norm_w, w_out, norm1_w, norm2_w, w_pq, sub_keys, u_tab, v_tab, normf_w):
    for l in range(DEPTH):
        h = rmsnorm(x, norm1_w[l])
        p = h @ w_in[l]
        z_rwkv, q, k, v = jnp.split(p, IN_SPLITS, axis=-1)
        y_rwkv = rwkv7_bidir(z_rwkv, mu_prev[l], mu_next[l], w0[l], w2[l], a0[l], a2[l], g2[l],
                             k_k[l], k_a[l], r_k[l], lnx_w[l], lnx_b[l]).astype(x.dtype)
        y_attn = axial_gqa(q, k, v, q_norm_w[l], k_norm_w[l])
        x = x + jnp.concatenate([y_rwkv, y_attn], axis=-1) @ w_out[l]
        h2 = rmsnorm(x, norm2_w[l])
        x = x + peer_ffn(h2, w_pq[l], sub_keys[l], u_tab[l], v_tab[l])
    return rmsnorm(x, normf_w)
```

```cpp
#include <hip/hip_runtime.h>
#include <cstdio>
#include <cstdint>
namespace pg8 {
#define PG8_LAS __attribute__((address_space(3)))
typedef unsigned short bf16_t;
typedef short bf16x8 __attribute__((ext_vector_type(8)));
typedef float f32x4 __attribute__((ext_vector_type(4)));
typedef unsigned u32x4 __attribute__((ext_vector_type(4)));
constexpr int BM = 256, BK = 64, HALF = 128, HTB = HALF * BK * 2  , STAGE_BYTES = 8 * HTB, NXCD = 8, WGM = 8;

__host__ __device__ __forceinline__ int lds_byte(int r, int c) { const int st = (r >> 4) * 2 + (c >> 5), rr = r & 15, cc = c & 31, ob = rr * 64 + cc * 2; return st * 1024 + (ob ^ (((ob >> 9) & 1) << 5)); }
__host__ __device__ __forceinline__ void stage_rc(int b, int& R, int& C) { const int st = b / 1024, sb = b % 1024, swz = sb ^ (((sb >> 9) & 1) << 5); R = (st >> 1) * 16 + swz / 64; C = (st & 1) * 32 + (swz % 64) / 2; }
__host__ __device__ __forceinline__ int perm32(int rho) { const int n = rho >> 4, i = rho & 15; return 8 * (i >> 2) + 4 * n + (i & 3); }

struct Unit { int pm, pn; };
struct Gemm { const bf16_t* A; const bf16_t* Bt; int M, N, K; };

struct StaticOrder {
    int nM, nN, nwg, G, c;
    __host__ __device__ void init(int M, int N, int G_, int c_) { nM = M / BM; nN = N / BM; nwg = nM * nN; G = G_; c = c_; }
    __host__ __device__ bool next(int i, Unit& u) const {
        const long L = (long)i * G + c; if (L >= nwg) return false;
        int wgid = (int)L; { const int q = nwg / NXCD, r = nwg % NXCD, xcd = wgid % NXCD, off = wgid / NXCD; wgid = (xcd < r ? xcd * (q + 1) : r * (q + 1) + (xcd - r) * q) + off; }
        const int nig = WGM * nN, gid = wgid / nig, fm = gid * WGM, gsz = (nM - fm) < WGM ? (nM - fm) : WGM;
        u.pm = fm + ((wgid % nig) % gsz); u.pn = (wgid % nig) / gsz; return true;
    }
    __device__ __forceinline__ void a_ready(const Unit&) const {}
    __device__ __forceinline__ void done(const Unit&) const {}
};

__device__ __forceinline__ unsigned cvt_pk_bf16(float lo, float hi) { unsigned r; asm volatile("v_cvt_pk_bf16_f32 %0, %1, %2" : "=v"(r) : "v"(lo), "v"(hi)); return r; }
typedef float f32x2 __attribute__((ext_vector_type(2)));
__device__ __forceinline__ f32x2 gelu_pk(f32x2 v) {
    const f32x2 av = __builtin_elementwise_abs(v), d = av * 0.2316418882f + 1.0f;
    f32x2 t; t.x = __builtin_amdgcn_rcpf(d.x); t.y = __builtin_amdgcn_rcpf(d.y);
    f32x2 q = t * 0.5307027145f + (-0.7265760135f); q = q * t + 0.7107068705f; q = q * t + (-0.142248368f); q = q * t + 0.127414796f; q = q * t;
    const f32x2 s = (v * v) * (-0.72134752044f);
    f32x2 e; e.x = __builtin_amdgcn_exp2f(s.x); e.y = __builtin_amdgcn_exp2f(s.y);
    const f32x2 m = v * (q * e), r = v - m;
    f32x2 o; o.x = v.x < 0.f ? m.x : r.x; o.y = v.y < 0.f ? m.y : r.y; return o;
}

template <int ACT  > struct EpiBf16 {
    static constexpr bool PERM = true, AFTER_DRAIN = false; static_assert(ACT == 0 || ACT == 1, "EpiBf16: ACT is 0 (none) or 1 (gelu_pk)");
    bf16_t* O; int ldc; const float* bias; int split_cols; size_t split_stride; float scale0;
    __device__ __forceinline__ void operator()(const f32x4 (&acc)[2][2][4][2], const Unit& u, int wr, int wc, int fr, int fq) const {
        const int row0 = u.pm * BM + wr * 64 + fr; int colt = u.pn * BM; bf16_t* base = O;
        float sc = 1.f; if (split_cols) { const int t = colt / split_cols; base += (size_t)t * split_stride; colt -= t * split_cols; if (t == 0) sc = scale0; }
        const int col0 = colt + wc * 32 + 8 * fq, bcol0 = u.pn * BM + wc * 32 + 8 * fq;
        f32x4 bv[2][2];
#pragma unroll
        for (int bj = 0; bj < 2; ++bj)
#pragma unroll
            for (int n = 0; n < 2; ++n) bv[bj][n] = bias ? *(const f32x4*)(bias + bcol0 + bj * HALF + 4 * n) : (f32x4){0.f, 0.f, 0.f, 0.f};
#pragma unroll
        for (int ai = 0; ai < 2; ++ai)
#pragma unroll
            for (int m = 0; m < 4; ++m) { bf16_t* rowp = base + (size_t)(row0 + ai * HALF + m * 16) * ldc + col0;
#pragma unroll
                for (int bj = 0; bj < 2; ++bj) { f32x4 v0 = acc[ai][bj][m][0] + bv[bj][0], v1 = acc[ai][bj][m][1] + bv[bj][1];
                    if (ACT == 1) { f32x2 a = gelu_pk((f32x2){v0[0], v0[1]}), b = gelu_pk((f32x2){v0[2], v0[3]}), c = gelu_pk((f32x2){v1[0], v1[1]}), d = gelu_pk((f32x2){v1[2], v1[3]});
                        v0 = (f32x4){a.x, a.y, b.x, b.y}; v1 = (f32x4){c.x, c.y, d.x, d.y}; }
                    v0 = v0 * sc; v1 = v1 * sc; u32x4 w; w.x = cvt_pk_bf16(v0[0], v0[1]); w.y = cvt_pk_bf16(v0[2], v0[3]); w.z = cvt_pk_bf16(v1[0], v1[1]); w.w = cvt_pk_bf16(v1[2], v1[3]);
                    *(u32x4*)(rowp + bj * HALF) = w; } }
    }
};
struct EpiF32Res {
    static constexpr bool PERM = false, AFTER_DRAIN = false;
    float* C; int ldc; const float* res;
    __device__ __forceinline__ void operator()(const f32x4 (&acc)[2][2][4][2], const Unit& u, int wr, int wc, int fr, int fq) const {
        const int row0 = u.pm * BM + wr * 64 + fr, col0 = u.pn * BM + wc * 32 + 4 * fq;
#pragma unroll
        for (int ai = 0; ai < 2; ++ai)
#pragma unroll
            for (int m = 0; m < 4; ++m) { const size_t off = (size_t)(row0 + ai * HALF + m * 16) * ldc + col0;
#pragma unroll
                for (int bj = 0; bj < 2; ++bj)
#pragma unroll
                    for (int n = 0; n < 2; ++n) { f32x4 v = acc[ai][bj][m][n]; if (res) v = v + *(const f32x4*)(res + off + bj * HALF + n * 16); *(f32x4*)(C + off + bj * HALF + n * 16) = v; } }
    }
};
struct EpiX2 {
    static constexpr bool PERM = true, AFTER_DRAIN = false;
    int ldc; const bf16_t* h1; const float* invr; const float* w; bf16_t* Xb;
    __device__ __forceinline__ void operator()(const f32x4 (&acc)[2][2][4][2], const Unit& u, int wr, int wc, int fr, int fq) const {
        const int row0 = u.pm * BM + wr * 64 + fr, col0 = u.pn * BM + wc * 32 + 8 * fq;
        f32x4 rw[2][2];
#pragma unroll
        for (int bj = 0; bj < 2; ++bj)
#pragma unroll
            for (int n = 0; n < 2; ++n) { const f32x4 wv = *(const f32x4*)(w + col0 + bj * HALF + 4 * n);
                rw[bj][n] = (f32x4){__builtin_amdgcn_rcpf(wv[0]), __builtin_amdgcn_rcpf(wv[1]), __builtin_amdgcn_rcpf(wv[2]), __builtin_amdgcn_rcpf(wv[3])}; }
#pragma unroll
        for (int ai = 0; ai < 2; ++ai)
#pragma unroll
            for (int m = 0; m < 4; ++m) { const int row = row0 + ai * HALF + m * 16; const size_t off = (size_t)row * ldc + col0; const float ir = invr[row];
#pragma unroll
                for (int bj = 0; bj < 2; ++bj) { const size_t o = off + bj * HALF; const u32x4 hw = __builtin_nontemporal_load((const u32x4*)(h1 + o));
                    const f32x4 x0 = (f32x4){__uint_as_float(hw.x << 16), __uint_as_float(hw.x & 0xffff0000u), __uint_as_float(hw.y << 16), __uint_as_float(hw.y & 0xffff0000u)};
                    const f32x4 x1 = (f32x4){__uint_as_float(hw.z << 16), __uint_as_float(hw.z & 0xffff0000u), __uint_as_float(hw.w << 16), __uint_as_float(hw.w & 0xffff0000u)};
                    const f32x4 v0 = acc[ai][bj][m][0] + x0 * ir * rw[bj][0], v1 = acc[ai][bj][m][1] + x1 * ir * rw[bj][1];
                    u32x4 w4; w4.x = cvt_pk_bf16(v0[0], v0[1]); w4.y = cvt_pk_bf16(v0[2], v0[3]); w4.z = cvt_pk_bf16(v1[0], v1[1]); w4.w = cvt_pk_bf16(v1[2], v1[3]);
                    *(u32x4*)(Xb + o) = w4; } }
    }
};
struct EpiF32P {
    static constexpr bool PERM = true, AFTER_DRAIN = false;
    float* C; int ldc;
    __device__ __forceinline__ void operator()(const f32x4 (&acc)[2][2][4][2], const Unit& u, int wr, int wc, int fr, int fq) const {
        const int row0 = u.pm * BM + wr * 64 + fr, col0 = u.pn * BM + wc * 32 + 8 * fq;
#pragma unroll
        for (int ai = 0; ai < 2; ++ai)
#pragma unroll
            for (int m = 0; m < 4; ++m) { const size_t off = (size_t)(row0 + ai * HALF + m * 16) * ldc + col0;
#pragma unroll
                for (int bj = 0; bj < 2; ++bj) { *(f32x4*)(C + off + bj * HALF) = acc[ai][bj][m][0]; *(f32x4*)(C + off + bj * HALF + 4) = acc[ai][bj][m][1]; } }
    }
};
struct EpiF16P {
    static constexpr bool PERM = true, AFTER_DRAIN = false;
    _Float16* C; int ldc;
    __device__ __forceinline__ void operator()(const f32x4 (&acc)[2][2][4][2], const Unit& u, int wr, int wc, int fr, int fq) const {
        typedef _Float16 h8 __attribute__((ext_vector_type(8)));
        const int row0 = u.pm * BM + wr * 64 + fr, col0 = u.pn * BM + wc * 32 + 8 * fq;
#pragma unroll
        for (int ai = 0; ai < 2; ++ai)
#pragma unroll
            for (int m = 0; m < 4; ++m) { const size_t off = (size_t)(row0 + ai * HALF + m * 16) * ldc + col0;
#pragma unroll
                for (int bj = 0; bj < 2; ++bj) { f32x4 v0 = acc[ai][bj][m][0], v1 = acc[ai][bj][m][1];
#pragma unroll
                    for (int j = 0; j < 4; ++j) { v0[j] = __builtin_amdgcn_fmed3f(v0[j], -60000.f, 60000.f); v1[j] = __builtin_amdgcn_fmed3f(v1[j], -60000.f, 60000.f); }
                    *(h8*)(C + off + bj * HALF) = (h8){(_Float16)v0[0], (_Float16)v0[1], (_Float16)v0[2], (_Float16)v0[3], (_Float16)v1[0], (_Float16)v1[1], (_Float16)v1[2], (_Float16)v1[3]}; } }
    }
};
template <class Epi, class Sched, bool ALIGN_EPI = false, bool SP2 = false>
__device__ __forceinline__ void gemm_phase(PG8_LAS unsigned char* lds, const Gemm g, const Sched& S, const Epi& E) {
    const int tid = threadIdx.x, wid = __builtin_amdgcn_readfirstlane(tid >> 6), lane = tid & 63, wr = wid >> 2, wc = wid & 3, fr = lane & 15, fq = lane >> 4;
    const int K = g.K, nt = K / BK;
    unsigned voffA[2], voffB[2];
#pragma unroll
    for (int i = 0; i < 2; ++i) { int R, C; stage_rc(tid * 16 + i * 8192, R, C); const int Rb = Epi::PERM ? ((R & ~31) + perm32(R & 31)) : R;
        voffA[i] = (unsigned)(R * K + C) * 2u; voffB[i] = (unsigned)(Rb * K + C) * 2u; }
    const size_t kstep = (size_t)(BK * 2);
    const size_t hstep = (size_t)HALF * K * 2;
    const size_t tstep = 2 * hstep;
    const unsigned ldsw = (unsigned)wid * 1024u;
    const int aoff = lds_byte(wr * 64 + fr, fq * 8), boff = lds_byte(wc * 32 + fr, fq * 8);
#define PG8_SA(b, h) (((b) * 2 + (h)) * HTB)
#define PG8_SB(b, h) ((4 + (b) * 2 + (h)) * HTB)
#define PG8_STAGE(bufoff, gbase, voff) do { _Pragma("unroll") for (int _i = 0; _i < 2; ++_i) \
        __builtin_amdgcn_global_load_lds((const unsigned*)((const char*)(gbase) + (voff)[_i]), (PG8_LAS unsigned*)(lds + (bufoff) + ldsw + _i * 8192), 16, 0, 0); } while (0)
#define PG8_LDA(dst, b, h) do { _Pragma("unroll") for (int m = 0; m < 4; ++m) _Pragma("unroll") for (int k = 0; k < 2; ++k) dst[m][k] = *(const PG8_LAS bf16x8*)(lds + PG8_SA(b, h) + aoff + m * 2048 + k * 1024); } while (0)
#define PG8_LDB(dst, b, h) do { _Pragma("unroll") for (int n = 0; n < 2; ++n) _Pragma("unroll") for (int k = 0; k < 2; ++k) dst[n][k] = *(const PG8_LAS bf16x8*)(lds + PG8_SB(b, h) + boff + n * 2048 + k * 1024); } while (0)
#define PG8_MMA(ai, bj, At, Bt) do { __builtin_amdgcn_s_setprio(1); _Pragma("unroll") for (int m = 0; m < 4; ++m) _Pragma("unroll") for (int n = 0; n < 2; ++n) _Pragma("unroll") for (int k = 0; k < 2; ++k) \
        acc[ai][bj][m][n] = __builtin_amdgcn_mfma_f32_16x16x32_bf16(Bt[n][k], At[m][k], acc[ai][bj][m][n], 0, 0, 0); __builtin_amdgcn_s_setprio(0); } while (0)
#define PG8_WAIT_V(n) asm volatile("s_waitcnt vmcnt(" #n ")" ::: "memory")
#define PG8_WAIT_L(n) asm volatile("s_waitcnt lgkmcnt(" #n ")" ::: "memory")
#define PG8_BAR __builtin_amdgcn_s_barrier()
#define PG8_SCHED __builtin_amdgcn_sched_barrier(0)
    Unit cur, nxt; int ui = 0;
    if (!S.next(0, cur)) return;
    f32x4 acc[2][2][4][2];
#pragma unroll
    for (int a = 0; a < 2; ++a)
#pragma unroll
        for (int b = 0; b < 2; ++b)
#pragma unroll
            for (int m = 0; m < 4; ++m)
#pragma unroll
                for (int n = 0; n < 2; ++n) acc[a][b][m][n] = (f32x4){0.f, 0.f, 0.f, 0.f};
    bf16x8 At[4][2], B0[2][2], B1[2][2];
    const char* cA = (const char*)g.A + (size_t)cur.pm * tstep; const char* cB = (const char*)g.Bt + (size_t)cur.pn * tstep;
    S.a_ready(cur);
    if constexpr (SP2) {
        PG8_STAGE(PG8_SB(0, 0), cB, voffB); PG8_STAGE(PG8_SB(0, 1), cB + hstep, voffB); PG8_STAGE(PG8_SA(0, 0), cA, voffA); PG8_STAGE(PG8_SA(0, 1), cA + hstep, voffA);
        if (wr == 1) PG8_BAR;
        PG8_WAIT_V(2); PG8_BAR;
        PG8_STAGE(PG8_SB(1, 0), cB + kstep, voffB); PG8_STAGE(PG8_SA(1, 0), cA + kstep, voffA); PG8_STAGE(PG8_SB(1, 1), cB + hstep + kstep, voffB);
        PG8_WAIT_V(6); PG8_BAR;
    } else {
        PG8_STAGE(PG8_SB(0, 0), cB, voffB); PG8_STAGE(PG8_SA(0, 0), cA, voffA); PG8_STAGE(PG8_SB(0, 1), cB + hstep, voffB); PG8_STAGE(PG8_SA(0, 1), cA + hstep, voffA);
        if (wr == 1) PG8_BAR;
        PG8_WAIT_V(4); PG8_BAR;
        PG8_STAGE(PG8_SB(1, 0), cB + kstep, voffB); PG8_STAGE(PG8_SA(1, 0), cA + kstep, voffA); PG8_STAGE(PG8_SB(1, 1), cB + hstep + kstep, voffB);
        PG8_WAIT_V(6); PG8_BAR;
    }
    for (;;) {
        const bool has_next = S.next(ui + 1, nxt);
        const char* nA = has_next ? (const char*)g.A + (size_t)nxt.pm * tstep : cA; const char* nB = has_next ? (const char*)g.Bt + (size_t)nxt.pn * tstep : cB;
        for (int t = 0; t < nt; t += 2) {
            const bool last = (t == nt - 2);
            const char* a1 = cA + (size_t)(t + 1) * kstep;
            const char* a2 = last ? nA : cA + (size_t)(t + 2) * kstep; const char* b2 = last ? nB : cB + (size_t)(t + 2) * kstep;
            const char* a3 = a2 + kstep; const char* b3 = b2 + kstep;
            if (last && has_next) S.a_ready(nxt);
            if constexpr (SP2) {
            PG8_LDB(B0, 0, 0); PG8_LDB(B1, 0, 1); PG8_SCHED; PG8_LDA(At, 0, 0); PG8_STAGE(PG8_SA(1, 1), a1 + hstep, voffA);
            PG8_WAIT_V(8); PG8_WAIT_L(0); PG8_BAR; PG8_MMA(0, 0, At, B0); PG8_MMA(0, 1, At, B1); PG8_BAR; PG8_SCHED;
            PG8_LDA(At, 0, 1); PG8_STAGE(PG8_SB(0, 0), b2, voffB); PG8_STAGE(PG8_SB(0, 1), b2 + hstep, voffB); PG8_STAGE(PG8_SA(0, 0), a2, voffA);
            PG8_WAIT_V(8); PG8_WAIT_L(0); PG8_BAR; PG8_MMA(1, 0, At, B0); PG8_MMA(1, 1, At, B1); PG8_BAR; PG8_SCHED;
            PG8_LDB(B0, 1, 0); PG8_LDB(B1, 1, 1); PG8_SCHED; PG8_LDA(At, 1, 0); PG8_STAGE(PG8_SA(0, 1), a2 + hstep, voffA);
            PG8_WAIT_V(8); PG8_WAIT_L(0); PG8_BAR; PG8_MMA(0, 0, At, B0); PG8_MMA(0, 1, At, B1); PG8_BAR; PG8_SCHED;
            PG8_LDA(At, 1, 1); PG8_STAGE(PG8_SB(1, 0), b3, voffB); PG8_STAGE(PG8_SB(1, 1), b3 + hstep, voffB); PG8_STAGE(PG8_SA(1, 0), a3, voffA);
            PG8_WAIT_V(8); PG8_WAIT_L(0); PG8_BAR; PG8_MMA(1, 0, At, B0); PG8_MMA(1, 1, At, B1); PG8_BAR; PG8_SCHED;
            } else {
            PG8_LDB(B0, 0, 0); PG8_SCHED; PG8_LDA(At, 0, 0); PG8_STAGE(PG8_SA(1, 1), a1 + hstep, voffA);
            PG8_WAIT_L(8); PG8_BAR; PG8_WAIT_L(0); PG8_MMA(0, 0, At, B0); PG8_BAR; PG8_SCHED;
            PG8_LDB(B1, 0, 1); PG8_STAGE(PG8_SB(0, 0), b2, voffB);
            PG8_BAR; PG8_WAIT_L(0); PG8_MMA(0, 1, At, B1); PG8_BAR;
            PG8_LDA(At, 0, 1); PG8_STAGE(PG8_SA(0, 0), a2, voffA);
            PG8_BAR; PG8_WAIT_L(0); PG8_MMA(1, 0, At, B0); PG8_BAR; PG8_SCHED;
            PG8_STAGE(PG8_SB(0, 1), b2 + hstep, voffB);
            PG8_WAIT_V(6); PG8_BAR; PG8_MMA(1, 1, At, B1); PG8_BAR;
            PG8_LDB(B0, 1, 0); PG8_SCHED; PG8_LDA(At, 1, 0); PG8_STAGE(PG8_SA(0, 1), a2 + hstep, voffA);
            PG8_WAIT_L(8); PG8_BAR; PG8_WAIT_L(0); PG8_MMA(0, 0, At, B0); PG8_BAR; PG8_SCHED;
            PG8_LDB(B1, 1, 1); PG8_STAGE(PG8_SB(1, 0), b3, voffB);
            PG8_BAR; PG8_WAIT_L(0); PG8_MMA(0, 1, At, B1); PG8_BAR;
            PG8_LDA(At, 1, 1); PG8_STAGE(PG8_SA(1, 0), a3, voffA);
            PG8_BAR; PG8_WAIT_L(0); PG8_MMA(1, 0, At, B0); PG8_BAR; PG8_SCHED;
            PG8_STAGE(PG8_SB(1, 1), b3 + hstep, voffB);
            PG8_WAIT_V(6); PG8_BAR; PG8_MMA(1, 1, At, B1); PG8_BAR;
            }
        }
        if constexpr (ALIGN_EPI) { if (wr == 0) PG8_BAR; }
        if constexpr (!Epi::AFTER_DRAIN) { E(acc, cur, wr, wc, fr, fq); S.done(cur); }
        if (!has_next) break;
#pragma unroll
        for (int a = 0; a < 2; ++a)
#pragma unroll
            for (int b = 0; b < 2; ++b)
#pragma unroll
                for (int m = 0; m < 4; ++m)
#pragma unroll
                    for (int n = 0; n < 2; ++n) acc[a][b][m][n] = (f32x4){0.f, 0.f, 0.f, 0.f};
        cur = nxt; cA = nA; cB = nB; ++ui;
        if constexpr (ALIGN_EPI) { if (wr == 1) PG8_BAR; }
    }
    PG8_WAIT_V(0);
    if constexpr (!ALIGN_EPI) { if (wr == 0) PG8_BAR; }
    PG8_BAR;
    if constexpr (Epi::AFTER_DRAIN) { E.fused(acc, cur, wr, wc, fr, fq, lds, wid, lane); S.done(cur); }
#undef PG8_SA
#undef PG8_SB
#undef PG8_STAGE
#undef PG8_LDA
#undef PG8_LDB
#undef PG8_MMA
#undef PG8_WAIT_V
#undef PG8_WAIT_L
#undef PG8_BAR
#undef PG8_SCHED
}
}
#include <hip/hip_bf16.h>
#include <cmath>
namespace attn_body {
using bf16=__hip_bfloat16;
using bf16x8=__attribute__((ext_vector_type(8)))short;
using s16x4=__attribute__((ext_vector_type(4)))short;
using f32x16=__attribute__((ext_vector_type(16)))float;
using u32x4=__attribute__((ext_vector_type(4)))unsigned;
constexpr int BATCH=8,NHEAD=16,SEQ=2048,D=64,PQ=5376,PO=2048;
constexpr int NW=8,QBLK=32,QB=QBLK*NW,KVBLK=64,NQB=SEQ/QB;
constexpr int ATTN_UNIT_ROWS=QB;
__device__ __forceinline__ int crow(int r,int hi){return (r&3)+8*(r>>2)+4*hi;}
#define SBAR() __builtin_amdgcn_sched_barrier(0)
constexpr int NSLOT=3, SLOTB=8192;
constexpr int LDS_K=0, LDS_V=NSLOT*SLOTB, LDS_WS=2*NSLOT*SLOTB, LDS_OST=LDS_WS+NW*64*4, LDS_BYTES=LDS_OST+NW*4096;
constexpr float C2=0.125f*1.4426950408889634f;
__device__ __forceinline__ void glds16(const void*gsrc,unsigned lds_dst){unsigned keep;
  asm volatile("s_mov_b32 %0, m0\n\ts_mov_b32 m0, %2\n\ts_nop 0\n\tglobal_load_lds_dwordx4 %1, off\n\ts_mov_b32 m0, %0":"=&s"(keep):"v"(gsrc),"s"(lds_dst):"memory");}
__device__ __forceinline__ float max3f(float a,float b,float c){float r;asm("v_max3_f32 %0, %1, %2, %3":"=v"(r):"v"(a),"v"(b),"v"(c));return r;}
__device__ __forceinline__ float max2f(float a,float b){float r;asm("v_max_f32_e32 %0, %1, %2":"=v"(r):"v"(a),"v"(b));return r;}
__device__ __forceinline__ float fadd_s(float a,float b){float r;asm("v_add_f32_e32 %0, %1, %2":"=v"(r):"v"(a),"v"(b));return r;}
__device__ __forceinline__ float fsub_s(float a,float b){float r;asm("v_sub_f32_e32 %0, %1, %2":"=v"(r):"v"(a),"v"(b));return r;}
typedef float f32x2_t __attribute__((ext_vector_type(2))); typedef __bf16 bf16x2_t __attribute__((ext_vector_type(2)));
__device__ __forceinline__ unsigned cvtpk_s(float lo,float hi){f32x2_t v={lo,hi};bf16x2_t b=__builtin_convertvector(v,bf16x2_t);return __builtin_bit_cast(unsigned,b);}
#define WAIT_BAR(N) asm volatile("s_waitcnt vmcnt(" #N ") lgkmcnt(0)\n\ts_barrier":::"memory")

__device__ __forceinline__ void qkt(f32x16&p0,f32x16&p1,const char*Kslot,const bf16x8*qr,const f32x16&negm,int r32,int hi){
  const char*kb=Kslot+hi*1024+r32*16;
  #pragma unroll
  for(int d0=0;d0<4;++d0){
    const bf16x8 b0=*reinterpret_cast<const bf16x8*>(kb+d0*2048);
    const bf16x8 b1=*reinterpret_cast<const bf16x8*>(kb+d0*2048+512);
    if(d0==0){p0=__builtin_amdgcn_mfma_f32_32x32x16_bf16(b0,qr[0],negm,0,0,0);p1=__builtin_amdgcn_mfma_f32_32x32x16_bf16(b1,qr[0],negm,0,0,0);}
    else{p0=__builtin_amdgcn_mfma_f32_32x32x16_bf16(b0,qr[d0],p0,0,0,0);p1=__builtin_amdgcn_mfma_f32_32x32x16_bf16(b1,qr[d0],p1,0,0,0);}}
}
typedef __attribute__((address_space(3))) const char* lds_cptr;
typedef short v4i16_t __attribute__((ext_vector_type(4)));
__device__ __forceinline__ void kload8(bf16x8*kf,lds_cptr kp){
  kf[0]=*(const __attribute__((address_space(3))) bf16x8*)(kp);      kf[1]=*(const __attribute__((address_space(3))) bf16x8*)(kp+512);
  kf[2]=*(const __attribute__((address_space(3))) bf16x8*)(kp+2048); kf[3]=*(const __attribute__((address_space(3))) bf16x8*)(kp+2560);
  kf[4]=*(const __attribute__((address_space(3))) bf16x8*)(kp+4096); kf[5]=*(const __attribute__((address_space(3))) bf16x8*)(kp+4608);
  kf[6]=*(const __attribute__((address_space(3))) bf16x8*)(kp+6144); kf[7]=*(const __attribute__((address_space(3))) bf16x8*)(kp+6656);
}
__device__ __forceinline__ void kload2(bf16x8*kf,lds_cptr kp,int j){ kf[2*j]=*(const __attribute__((address_space(3))) bf16x8*)(kp+j*2048); kf[2*j+1]=*(const __attribute__((address_space(3))) bf16x8*)(kp+j*2048+512); }
__device__ __forceinline__ s16x4 vtr(lds_cptr p){ return __builtin_bit_cast(s16x4,__builtin_amdgcn_ds_read_tr16_b64_v4i16((__attribute__((address_space(3))) v4i16_t*)p)); }
__device__ __forceinline__ float rowmax(const f32x16&p0,const f32x16&p1){
  float a=max3f(p0[0],p0[1],p1[0]),b=max3f(p0[2],p0[3],p1[1]);a=max3f(a,p1[2],p1[3]);
  #pragma unroll
  for(int r=4;r<16;r+=4){a=max3f(a,p0[r],p0[r+1]);b=max3f(b,p0[r+2],p0[r+3]);a=max3f(a,p1[r],p1[r+1]);b=max3f(b,p1[r+2],p1[r+3]);}
  const float m=max2f(a,b);
  auto rr=__builtin_amdgcn_permlane32_swap(__float_as_uint(m),__float_as_uint(m),false,false);
  return max2f(__uint_as_float(rr[0]),__uint_as_float(rr[1]));
}
__device__ __forceinline__ void pv(f32x16*o,int vb,bf16x8 pa0,bf16x8 pa1,bf16x8 pa2,bf16x8 pa3){
  #pragma unroll
  for(int d0=0;d0<2;++d0){s16x4 lo[4],hi[4];
    #pragma unroll
    for(int ks=0;ks<4;++ks){
      asm volatile("ds_read_b64_tr_b16 %0,%1 offset:%c2":"=&v"(lo[ks]):"v"(vb),"i"(d0*4096+ks*1024):"memory");
      asm volatile("ds_read_b64_tr_b16 %0,%1 offset:%c2":"=&v"(hi[ks]):"v"(vb),"i"(d0*4096+ks*1024+512):"memory");}
    asm volatile("s_waitcnt lgkmcnt(0)":::"memory");SBAR();
    #define PK(k) (bf16x8){lo[k][0],lo[k][1],lo[k][2],lo[k][3],hi[k][0],hi[k][1],hi[k][2],hi[k][3]}
    o[d0]=__builtin_amdgcn_mfma_f32_32x32x16_bf16(pa0,PK(0),o[d0],0,0,0);
    o[d0]=__builtin_amdgcn_mfma_f32_32x32x16_bf16(pa1,PK(1),o[d0],0,0,0);
    o[d0]=__builtin_amdgcn_mfma_f32_32x32x16_bf16(pa2,PK(2),o[d0],0,0,0);
    o[d0]=__builtin_amdgcn_mfma_f32_32x32x16_bf16(pa3,PK(3),o[d0],0,0,0);
    #undef PK
  }
}

#ifndef ATTN_STORE16
#define ATTN_STORE16(p,v) (*(u32x4*)(p)=(v))
#endif
template<int THRL> __device__ __forceinline__ void attn_unit(int b,int h,int qb,const bf16*Q,const bf16*__restrict__ K,const bf16*__restrict__ V,bf16*O,char*shm){
  const int tid=threadIdx.x,lane=tid&63,r32=lane&31,hi=lane>>5; const int wid=__builtin_amdgcn_readfirstlane(tid>>6);
  const long rowbase=(long)b*SEQ; const int q0=qb*QB;
  const bf16*Qw=Q+(rowbase+q0+wid*QBLK)*PQ+h*D;
  const bf16*Kh=K+rowbase*PQ+(h>>2)*D,*Vh=V+rowbase*PQ+(h>>2)*D;
  const unsigned lds0=(unsigned)(uintptr_t)shm;
  float*wsf=(float*)(shm+LDS_WS)+wid*64;
  const bf16*ksrc=Kh+(long)lane*PQ+wid*8;
  const bf16*vsrc=Vh+(long)(16*(wid&3)+(lane>>2))*PQ+(wid>>2)*32+(lane&3)*8;
  const unsigned kdst=lds0+LDS_K+wid*1024, vdst=lds0+LDS_V+wid*1024;
  #define DMA_K(t,slot) glds16(ksrc+(long)(t)*KVBLK*PQ,(unsigned)__builtin_amdgcn_readfirstlane(kdst+(slot)))
  #define DMA_V(t,slot) glds16(vsrc+(long)(t)*KVBLK*PQ,(unsigned)__builtin_amdgcn_readfirstlane(vdst+(slot)))
  const int vb0=(int)(lds0+LDS_V)+((lane>>4)&1)*32+(lane&3)*8+(4*hi+((lane&15)>>2))*64;
  const char*Kbase=shm+LDS_K; bf16x8 kf[8];
  const lds_cptr shm3=(lds_cptr)shm; const lds_cptr kp0=shm3+LDS_K+hi*1024+r32*16; const lds_cptr vp0=shm3+LDS_V+((lane>>4)&1)*32+(lane&3)*8+(4*hi+((lane&15)>>2))*64;
  const int NT=SEQ/KVBLK;
  DMA_K(0,0);DMA_V(0,0);DMA_K(1,SLOTB);
  bf16x8 qr[4];
  #pragma unroll
  for(int d0=0;d0<4;++d0)qr[d0]=*reinterpret_cast<const bf16x8*>(&Qw[(long)r32*PQ+d0*16+hi*8]);
  float mhat=0.f,l_reg=0.f;f32x16 o[2];o[0]=f32x16{};o[1]=f32x16{};f32x16 negm=f32x16{};asm volatile("":"+v"(negm));
  #define CMASK(P0,P1,t) do{}while(0)
  bool resc=false;
  #define START(P0,P1) do{ const float rm=rowmax(P0,P1); resc=false; \
    { const float dl=rm; mhat=fadd_s(mhat,dl); \
      _Pragma("unroll") for(int r=0;r<16;++r){P0[r]=fsub_s(P0[r],dl);P1[r]=fsub_s(P1[r],dl);} \
      _Pragma("unroll") for(int r=0;r<16;++r)negm[r]=-mhat; asm volatile("":"+v"(negm)); } \
    _Pragma("unroll") for(int r=0;r<16;++r)P0[r]=__builtin_amdgcn_exp2f(P0[r]); }while(0)
  #define RESC() do{ if(resc){ asm volatile("s_waitcnt lgkmcnt(0)":::"memory"); \
      _Pragma("unroll") for(int d_=0;d_<2;++d_) _Pragma("unroll") for(int r=0;r<16;++r)o[d_][r]*=wsf[crow(r,hi)]; } }while(0)
  f32x16 pA0,pA1,pB0,pB1;
  int sl_prev=0,sl_cur=0,sl_next=SLOTB;
  #define ROT() do{sl_prev=sl_cur;sl_cur=sl_next;sl_next=(sl_next==(NSLOT-1)*SLOTB)?0:sl_next+SLOTB;}while(0)
  DMA_K(2,2*SLOTB);
  WAIT_BAR(3);
  qkt(pA0,pA1,Kbase,qr,negm,r32,hi);asm volatile("s_nop 15\n\ts_nop 7":"+v"(pA0),"+v"(pA1));CMASK(pA0,pA1,0);
  START(pA0,pA1);
  _Pragma("unroll") for(int r=0;r<16;++r)pA1[r]=__builtin_amdgcn_exp2f(pA1[r]);
  WAIT_BAR(0);
  DMA_K(3,0);DMA_V(1,SLOTB);
  ROT();
  kload8(kf,kp0+sl_cur);
  WAIT_BAR(2);
  s16x4 vlo[8],vhi[8]; u32x4 pw0,pw1,pw2,pw3;
  #define PKW(P,B) cvtpk_s(P[B],P[B+1])
  #define PAF(k) __builtin_bit_cast(bf16x8,pw##k)
  #define VFR(i) (bf16x8){vlo[i][0],vlo[i][1],vlo[i][2],vlo[i][3],vhi[i][0],vhi[i][1],vhi[i][2],vhi[i][3]}
  #define PIN(x) asm volatile("":"+v"(x))
  #define MX3(a,b,c) __builtin_fmaxf(__builtin_fmaxf((a),(b)),(c))
  #define GAPA(MF,A0,A1,A2,A3,W0,W1,PW) do{ MF; sacc+=A0; sacc+=A1; sacc+=A2; sacc+=A3; PIN(sacc); W0; W1; PIN(PW); SBAR(); }while(0)
  #define EX(v) __builtin_amdgcn_exp2f(v)
  #define GAPB(MF,X,B) do{ MF; X[B]=EX(X[B]); X[B+1]=EX(X[B+1]); X[B+2]=EX(X[B+2]); X[B+3]=EX(X[B+3]); PIN(X); SBAR(); }while(0)
  #define VRD(i) do{ vlo[i]=vtr(vp_+(((i)>>2)*4096+((i)&3)*1024)); vhi[i]=vtr(vp_+(((i)>>2)*4096+((i)&3)*1024+512)); }while(0)
  #define KRD(G,j) do{ if(G){ kload2(kf,kp0+sl_next,j); SBAR(); } }while(0)
  #define STEP(C0,C1,P0,P1,t,GK,GV,GL) do{ SBAR(); \
    const lds_cptr vp_=vp0+sl_prev; \
    VRD(0); SBAR(); float sacc=(P0[0]+P0[1]); \
    GAPA(C0=__builtin_amdgcn_mfma_f32_32x32x16_bf16(kf[0],qr[0],negm,0,0,0), P0[2],P0[3],P0[4],P0[5],     pw0[0]=PKW(P0,0), pw0[1]=PKW(P0,2), pw0); \
    VRD(4); SBAR(); GAPA(C1=__builtin_amdgcn_mfma_f32_32x32x16_bf16(kf[1],qr[0],negm,0,0,0), P0[6],P0[7],P0[8],P0[9],     pw0[2]=PKW(P0,4), pw0[3]=PKW(P0,6), pw0); \
    VRD(1); SBAR(); GAPA(C0=__builtin_amdgcn_mfma_f32_32x32x16_bf16(kf[2],qr[1],C0,0,0,0),   P0[10],P0[11],P0[12],P0[13], pw1[0]=PKW(P0,8), pw1[1]=PKW(P0,10), pw1); \
    VRD(5); SBAR(); GAPA(C1=__builtin_amdgcn_mfma_f32_32x32x16_bf16(kf[3],qr[1],C1,0,0,0),   P0[14],P0[15],P1[0],P1[1],   pw1[2]=PKW(P0,12),pw1[3]=PKW(P0,14), pw1); \
    VRD(2); SBAR(); GAPA(C0=__builtin_amdgcn_mfma_f32_32x32x16_bf16(kf[4],qr[2],C0,0,0,0),   P1[2],P1[3],P1[4],P1[5],     pw2[0]=PKW(P1,0), pw2[1]=PKW(P1,2), pw2); \
    VRD(6); SBAR(); GAPA(C1=__builtin_amdgcn_mfma_f32_32x32x16_bf16(kf[5],qr[2],C1,0,0,0),   P1[6],P1[7],P1[8],P1[9],     pw2[2]=PKW(P1,4), pw2[3]=PKW(P1,6), pw2); \
    VRD(3); SBAR(); GAPA(C0=__builtin_amdgcn_mfma_f32_32x32x16_bf16(kf[6],qr[3],C0,0,0,0),   P1[10],P1[11],P1[12],P1[13], pw3[0]=PKW(P1,8), pw3[1]=PKW(P1,10), pw3); \
    VRD(7); SBAR(); GAPA(C1=__builtin_amdgcn_mfma_f32_32x32x16_bf16(kf[7],qr[3],C1,0,0,0),   P1[14],P1[15],0.f,0.f,       pw3[2]=PKW(P1,12),pw3[3]=PKW(P1,14), pw3); \
    l_reg+=sacc; \
    if(GK){DMA_K((t)+3,sl_cur);} if(GV){DMA_V((t)+1,sl_next);} \
    CMASK(C0,C1,t); \
    { float a=MX3(C0[0],C0[1],C1[0]),b=MX3(C0[2],C0[3],C1[1]); a=MX3(a,C1[2],C1[3]); \
      _Pragma("unroll") for(int r=4;r<16;r+=4){a=MX3(a,C0[r],C0[r+1]);b=MX3(b,C0[r+2],C0[r+3]);a=MX3(a,C1[r],C1[r+1]);b=MX3(b,C1[r+2],C1[r+3]);} \
      float rm=__builtin_fmaxf(a,b); { auto rr=__builtin_amdgcn_permlane32_swap(__float_as_uint(rm),__float_as_uint(rm),false,false); rm=__builtin_fmaxf(__uint_as_float(rr[0]),__uint_as_float(rr[1])); } \
      resc=false; \
      if(__builtin_expect(__any(rm>(float)THRL),0)){ const float dl=__builtin_fmaxf(rm,0.f); mhat+=dl; \
        _Pragma("unroll") for(int r=0;r<16;++r){C0[r]-=dl;C1[r]-=dl;} \
        _Pragma("unroll") for(int r=0;r<16;++r)negm[r]=-mhat; asm volatile("":"+v"(negm)); \
        const float f=__builtin_amdgcn_exp2f(-dl); l_reg*=f; if(hi==0)wsf[r32]=f; resc=true; } } \
    SBAR(); \
    GAPB(o[0]=__builtin_amdgcn_mfma_f32_32x32x16_bf16(PAF(0),VFR(0),o[0],0,0,0), C0,0); \
    GAPB(o[1]=__builtin_amdgcn_mfma_f32_32x32x16_bf16(PAF(0),VFR(4),o[1],0,0,0), C0,4); \
    KRD(GL,0); GAPB(o[0]=__builtin_amdgcn_mfma_f32_32x32x16_bf16(PAF(1),VFR(1),o[0],0,0,0), C0,8); \
    KRD(GL,1); GAPB(o[1]=__builtin_amdgcn_mfma_f32_32x32x16_bf16(PAF(1),VFR(5),o[1],0,0,0), C0,12); \
    KRD(GL,2); GAPB(o[0]=__builtin_amdgcn_mfma_f32_32x32x16_bf16(PAF(2),VFR(2),o[0],0,0,0), C1,0); \
    KRD(GL,3); GAPB(o[1]=__builtin_amdgcn_mfma_f32_32x32x16_bf16(PAF(2),VFR(6),o[1],0,0,0), C1,4); \
    GAPB(o[0]=__builtin_amdgcn_mfma_f32_32x32x16_bf16(PAF(3),VFR(3),o[0],0,0,0), C1,8); \
    GAPB(o[1]=__builtin_amdgcn_mfma_f32_32x32x16_bf16(PAF(3),VFR(7),o[1],0,0,0), C1,12); \
    }while(0)
  int t=1;
  #undef CMASK
  #define CMASK(P0,P1,t) do{}while(0)
  for(;t+5<NT;t+=2){
    STEP(pB0,pB1,pA0,pA1,t,true,true,true);     WAIT_BAR(2); RESC(); ROT();
    STEP(pA0,pA1,pB0,pB1,t+1,true,true,true);   WAIT_BAR(2); RESC(); ROT();
  }
  #undef CMASK
  #define CMASK(P0,P1,t) do{}while(0)
  #define ENDW(tt) do{ if((tt)+3<NT){WAIT_BAR(2);} else if((tt)+2<NT){WAIT_BAR(1);} else {WAIT_BAR(0);} }while(0)
  for(;t+1<NT;t+=2){
    STEP(pB0,pB1,pA0,pA1,t,(t+3<NT),(t+1<NT),(t+1<NT));       ENDW(t);   RESC(); ROT();
    STEP(pA0,pA1,pB0,pB1,t+1,(t+4<NT),(t+2<NT),(t+2<NT));     ENDW(t+1); RESC(); ROT();
  }
  STEP(pB0,pB1,pA0,pA1,NT-1,false,false,false); RESC();
  { float sacc=pB0[0]+pB0[1]; _Pragma("unroll") for(int r=2;r<16;++r)sacc+=pB0[r]; _Pragma("unroll") for(int r=0;r<16;++r)sacc+=pB1[r]; l_reg+=sacc;
    pw0=(u32x4){PKW(pB0,0),PKW(pB0,2),PKW(pB0,4),PKW(pB0,6)};pw1=(u32x4){PKW(pB0,8),PKW(pB0,10),PKW(pB0,12),PKW(pB0,14)};pw2=(u32x4){PKW(pB1,0),PKW(pB1,2),PKW(pB1,4),PKW(pB1,6)};pw3=(u32x4){PKW(pB1,8),PKW(pB1,10),PKW(pB1,12),PKW(pB1,14)};
    SBAR(); pv(o,vb0+sl_cur,PAF(0),PAF(1),PAF(2),PAF(3)); }
  #undef PKW
  #undef PAF
  #undef VFR
  #undef PIN
  #undef MX3
  #undef GAPA
  #undef GAPB
  #undef EX
  #undef VRD
  #undef KRD
  #undef STEP
  #undef ENDW
  {auto rr=__builtin_amdgcn_permlane32_swap(__float_as_uint(l_reg),__float_as_uint(l_reg),false,false);l_reg=__uint_as_float(rr[0])+__uint_as_float(rr[1]);}
  if(hi==0)wsf[32+r32]=l_reg;asm volatile("s_waitcnt lgkmcnt(0)":::"memory");
  float rli[16];
  #pragma unroll
  for(int r=0;r<16;++r)rli[r]=__builtin_amdgcn_rcpf(wsf[32+crow(r,hi)]);
  bf16*Ow=O+(rowbase+q0+wid*QBLK)*PO+h*D;
  { bf16*stg=(bf16*)(shm+LDS_OST)+wid*2048;
    #pragma unroll
    for(int r=0;r<16;++r){const int orow=crow(r,hi);
      #pragma unroll
      for(int d0=0;d0<2;++d0)stg[orow*64+d0*32+r32]=__float2bfloat16(o[d0][r]*rli[r]);}
    asm volatile("s_waitcnt lgkmcnt(0)":::"memory");
    #pragma unroll
    for(int i=0;i<4;++i){const int row=i*8+(lane>>3),ch=lane&7; const u32x4 v=*(const u32x4*)(stg+row*64+ch*8); ATTN_STORE16(Ow+(long)row*PO+ch*8,v);} }
  asm volatile("s_waitcnt lgkmcnt(0)\n\ts_barrier":::"memory");
  #undef DMA_K
  #undef DMA_V
  #undef CMASK
  #undef START
  #undef RESC
  #undef ROT
}
constexpr int ATTN_LDS_BYTES=LDS_BYTES;
struct AttnTensors { const bf16* Q; const bf16* K; const bf16* V; bf16* O; };
struct AttnUnit { int b; int h; int qb; };
struct StaticOrder {
  int vcu, G;
  __device__ __forceinline__ explicit StaticOrder(int grid,int v):vcu(v),G(grid){}
  __device__ __forceinline__ bool next(int i,AttnUnit&u)const{ const int id=vcu+i*G; if(id>=1024)return false; const int w=id&255, r=id>>8; const int bk=w>>3; u.b=bk>>2; u.h=(bk&3)*4+r; u.qb=w&7; return true; }
  __device__ __forceinline__ void a_ready(const AttnUnit&)const{}
  __device__ __forceinline__ void done(const AttnUnit&)const{}
};
template<class Sched,int THRL=8> __device__ __forceinline__ void attn_phase(char*lds,const AttnTensors&T,const Sched&S){
  AttnUnit u;
  for(int i=0;S.next(i,u);++i){ S.a_ready(u); attn_unit<THRL>(u.b,u.h,u.qb,T.Q,T.K,T.V,T.O,lds); S.done(u); }
}
#undef SBAR
#undef WAIT_BAR
}
constexpr int NWAVES = 8;
constexpr int T_TOK = 16384, SEQL = 2048, DMODEL = 2048, PC = 5376;
constexpr int COL_R = 0, COL_K = 1024, COL_V = 2048, COL_LORA = 3072, COL_Q = 3712, COL_KA = 4736, COL_VA = 4992;
#ifndef MK_ONE_LAUNCH
#define MK_ONE_LAUNCH 1
#endif
constexpr int N_PHASES = 9;
#ifndef REP_P
#define REP_P -1
#define REP_N 1
#endif
#define NREP(k) (((k) == REP_P) ? REP_N : 1)
#ifndef PEER_RIF
#define PEER_RIF 8
#endif
#ifndef SCAN_INV_MFMA
#define SCAN_INV_MFMA 1
#endif
constexpr size_t MiB = 1u << 20;
constexpr size_t WS_CTL = 0, CTL_ZERO_BYTES = 64 * 1024;
constexpr size_t WS_ROPE = 1 * MiB;
constexpr size_t WS_WINT = 2 * MiB, WS_WOUTT = 23 * MiB, WS_WST = 31 * MiB, WS_LORA = 39 * MiB;
constexpr size_t WS_H = 41 * MiB;
constexpr size_t WS_P = 105 * MiB;
constexpr size_t WS_AR = 273 * MiB, WS_G = 337 * MiB, WS_Y = 369 * MiB, WS_TAB = 433 * MiB, WS_END = 498 * MiB;
constexpr int CW_BAR = 4096;
constexpr int RING_BYTES = 131072, LDSCTL_OFF = RING_BYTES, MISC_OFF = LDSCTL_OFF + 320, LDS_BYTES = 147456;

#define GAS __attribute__((address_space(1)))
#define LAS __attribute__((address_space(3)))
typedef unsigned short bf16;
typedef unsigned v4u __attribute__((ext_vector_type(4)));
typedef unsigned v2u __attribute__((ext_vector_type(2)));
typedef float f32x4 __attribute__((ext_vector_type(4)));
typedef float f32x2 __attribute__((ext_vector_type(2)));
typedef float f32x16 __attribute__((ext_vector_type(16)));
typedef float f32x32 __attribute__((ext_vector_type(32)));
typedef unsigned v6u __attribute__((ext_vector_type(6)));
typedef short bf16x8 __attribute__((ext_vector_type(8)));
typedef __bf16 bf16x2v __attribute__((ext_vector_type(2)));
typedef GAS unsigned gu32;
#define RLX_AGENT __ATOMIC_RELAXED, __HIP_MEMORY_SCOPE_AGENT
#define LDS_WAIT() asm volatile("s_waitcnt lgkmcnt(0)" ::: "memory")
__device__ __forceinline__ unsigned f2bf(float f) { unsigned u = __builtin_bit_cast(unsigned, f); return (u + 0x7fffu + ((u >> 16) & 1u)) >> 16; }
__device__ __forceinline__ unsigned pk2(float lo, float hi) { return f2bf(lo) | (f2bf(hi) << 16); }
__device__ __forceinline__ unsigned pk2c(float lo, float hi) { const f32x2 v = {lo, hi}; const bf16x2v b = __builtin_convertvector(v, bf16x2v); return __builtin_bit_cast(unsigned, b); }
__device__ __forceinline__ float bf2f(unsigned short u) { return __uint_as_float((unsigned)u << 16); }
__device__ __forceinline__ float bflo(unsigned w) { return __uint_as_float(w << 16); }
__device__ __forceinline__ float bfhi(unsigned w) { return __uint_as_float(w & 0xffff0000u); }
__device__ __forceinline__ float sigmoid_f(float x) { return __builtin_amdgcn_rcpf(1.0f + __expf(-x)); }
__device__ __forceinline__ float tanh_f(float x) { return 1.0f - 2.0f * __builtin_amdgcn_rcpf(__expf(2.0f * x) + 1.0f); }
__device__ __forceinline__ float dot2bf(unsigned a, unsigned b, float acc) { return __builtin_amdgcn_fdot2_f32_bf16(__builtin_bit_cast(bf16x2v, a), __builtin_bit_cast(bf16x2v, b), acc, false); }
template <int CTRL> __device__ __forceinline__ float dppf(float x) { return __builtin_bit_cast(float, __builtin_amdgcn_mov_dpp(__builtin_bit_cast(int, x), CTRL, 0xf, 0xf, true)); }
template <int CTRL> __device__ __forceinline__ unsigned dppu(unsigned x) { return (unsigned)__builtin_amdgcn_mov_dpp((int)x, CTRL, 0xf, 0xf, true); }
__device__ __forceinline__ float allred16(float x) { x += dppf<0xB1>(x); x += dppf<0x4E>(x); x += dppf<0x141>(x); x += dppf<0x128>(x); return x; }
__device__ __forceinline__ float wave_sum(float v) {
    v += dppf<0xB1>(v); v += dppf<0x4E>(v); v += dppf<0x141>(v); v += dppf<0x140>(v);
    { const auto r = __builtin_amdgcn_permlane16_swap(__float_as_uint(v), __float_as_uint(v), false, false); v = __uint_as_float(r[0]) + __uint_as_float(r[1]); }
    { const auto r = __builtin_amdgcn_permlane32_swap(__float_as_uint(v), __float_as_uint(v), false, false); v = __uint_as_float(r[0]) + __uint_as_float(r[1]); }
    return v;
}
__device__ __forceinline__ void allred16x2(float& a, float& b) {
    asm("s_nop 1\n\t"
        "v_add_f32_dpp %0, %0, %0 quad_perm:[1,0,3,2] row_mask:0xf bank_mask:0xf\n\t"
        "v_add_f32_dpp %1, %1, %1 quad_perm:[1,0,3,2] row_mask:0xf bank_mask:0xf\n\t"
        "s_nop 0\n\t"
        "v_add_f32_dpp %0, %0, %0 quad_perm:[2,3,0,1] row_mask:0xf bank_mask:0xf\n\t"
        "v_add_f32_dpp %1, %1, %1 quad_perm:[2,3,0,1] row_mask:0xf bank_mask:0xf\n\t"
        "s_nop 0\n\t"
        "v_add_f32_dpp %0, %0, %0 row_half_mirror row_mask:0xf bank_mask:0xf\n\t"
        "v_add_f32_dpp %1, %1, %1 row_half_mirror row_mask:0xf bank_mask:0xf\n\t"
        "s_nop 0\n\t"
        "v_add_f32_dpp %0, %0, %0 row_ror:8 row_mask:0xf bank_mask:0xf\n\t"
        "v_add_f32_dpp %1, %1, %1 row_ror:8 row_mask:0xf bank_mask:0xf\n\t"
        "s_nop 0"
        : "+v"(a), "+v"(b));
}
__device__ __forceinline__ float wave_max(float v) {
    v = fmaxf(v, dppf<0xB1>(v)); v = fmaxf(v, dppf<0x4E>(v)); v = fmaxf(v, dppf<0x141>(v)); v = fmaxf(v, dppf<0x140>(v));
    { const auto r = __builtin_amdgcn_permlane16_swap(__float_as_uint(v), __float_as_uint(v), false, false); v = fmaxf(__uint_as_float(r[0]), __uint_as_float(r[1])); }
    { const auto r = __builtin_amdgcn_permlane32_swap(__float_as_uint(v), __float_as_uint(v), false, false); v = fmaxf(__uint_as_float(r[0]), __uint_as_float(r[1])); }
    return v;
}
__device__ __forceinline__ unsigned umax(unsigned a, unsigned b) { return a > b ? a : b; }
__device__ __forceinline__ unsigned f2sort(float f) { const unsigned u = __float_as_uint(f); return u ^ ((unsigned)((int)u >> 31) | 0x80000000u); }
__device__ __forceinline__ float sort2f(unsigned k) { const unsigned u = (k & 0x80000000u) ? (k ^ 0x80000000u) : ~k; return __uint_as_float(u); }
__device__ __forceinline__ float gelu_f(float v) {
    const float av = fabsf(v), t = __builtin_amdgcn_rcpf(av * 0.2316418882f + 1.0f);
    float q = t * 0.5307027145f + (-0.7265760135f); q = q * t + 0.7107068705f; q = q * t + (-0.142248368f); q = q * t + 0.127414796f; q = q * t;
    const float e = __builtin_amdgcn_exp2f((v * v) * (-0.72134752044f));
    const float m = v * (q * e);
    return v < 0.f ? m : v - m;
}

__device__ const unsigned char kStair[56] = {0, 1, 2, 3, 4, 5, 6, 7, 8, 9, 10, 11, 12, 13, 14, 15, 16, 17, 18, 19, 20, 21, 22, 23, 32, 33, 34, 35, 36, 48, 49, 50, 51, 64, 65, 66, 80, 81, 96, 97, 112, 113, 128, 144, 160, 176, 192, 208, 224, 240, 255, 255, 255, 255, 255, 255};
__device__ const double kRopeInv[16] = {1.0, 0.5623413251903491, 0.31622776601683794, 0.1778279410038923, 0.1, 0.05623413251903491, 0.031622776601683794, 0.01778279410038923,
                                        0.01, 0.005623413251903491, 0.0031622776601683794, 0.001778279410038923, 0.001, 0.0005623413251903491, 0.00031622776601683794, 0.0001778279410038923};

#define XB_TMO      128
#define XB_XCNT(j)  (256  + 64 * (j))
#define XB_XSUB(j)  (1280 + 64 * (j))
#define XB_XGEN(j)  (2304 + 64 * (j))
#define XB_TOP      3328
#define XB_TOPGEN   3392
#define XCD_BAR_WORDS 3456
#define XB_SPIN_CAP (1u << 18)

__device__ __forceinline__ unsigned xb_ld(unsigned* p)              { return __hip_atomic_load(p, __ATOMIC_RELAXED, __HIP_MEMORY_SCOPE_AGENT); }
__device__ __forceinline__ unsigned xb_add(unsigned* p, unsigned v) { return __hip_atomic_fetch_add(p, v, __ATOMIC_RELAXED, __HIP_MEMORY_SCOPE_AGENT); }
__device__ __forceinline__ unsigned xb_xcc_id() { return (unsigned)__builtin_amdgcn_s_getreg((3 << 11) | 20) & 0xFu; }
#define XB_SPIN(cond, bar) do { unsigned _sp = 0; while (cond) { __builtin_amdgcn_s_sleep(1); \
    if ((++_sp & 255u) == 0u) { if (xb_ld(&(bar)[XB_TMO])) break; if (_sp > XB_SPIN_CAP) { atomicAdd(&(bar)[XB_TMO], 1u); break; } } } } while (0)

struct XcdBarrier {
    unsigned* bar; unsigned x;
    volatile LAS unsigned* st;
};

__device__ __forceinline__ XcdBarrier xcd_barrier_post(unsigned* bar, volatile LAS unsigned* st) {
    XcdBarrier b; b.bar = bar; b.x = xb_xcc_id(); b.st = st;
    if (threadIdx.x == 0) (void)xb_add(&bar[XB_XCNT(b.x)], 1u);
    return b;
}
__device__ __forceinline__ void xcd_barrier_complete(unsigned* bar, unsigned x, unsigned& nloc, unsigned& nx) {
    const unsigned G = gridDim.x * gridDim.y * gridDim.z;
    unsigned sum, cnt, mine, sp = 0u;
    for (;;) {
        sum = 0u; cnt = 0u; mine = 0u;
#pragma unroll
        for (unsigned j = 0; j < 16; ++j) { const unsigned c = xb_ld(&bar[XB_XCNT(j)]); sum += c; cnt += (c > 0u) ? 1u : 0u; mine = (j == x) ? c : mine; }
        if (sum == G) break;
        __builtin_amdgcn_s_sleep(1);
        if ((++sp & 255u) == 0u) { if (xb_ld(&bar[XB_TMO])) break; if (sp > XB_SPIN_CAP) { atomicAdd(&bar[XB_TMO], 1u); break; } }
    }
    nloc = mine > 0u ? mine : 1u; nx = cnt > 0u ? cnt : 1u;
}

__device__ __forceinline__ void xcd_barrier(const XcdBarrier& b) {
    asm volatile("s_waitcnt vmcnt(0)" ::: "memory");
    __syncthreads();
    if (threadIdx.x == 0) {
        unsigned* bar = b.bar;
        __builtin_amdgcn_s_waitcnt(0);
        unsigned nloc = b.st[0], nx = b.st[1];
        if (nloc == 0u) { xcd_barrier_complete(bar, b.x, nloc, nx); b.st[0] = nloc; b.st[1] = nx; }
        const unsigned old = xb_add(&bar[XB_XSUB(b.x)], 1u);
        const unsigned gen = old / nloc;
        if (old + 1u == (gen + 1u) * nloc) {
            __builtin_amdgcn_fence(__ATOMIC_RELEASE, "agent");
            asm volatile("s_waitcnt vmcnt(0)" ::: "memory");
            const unsigned og = xb_add(&bar[XB_TOP], 1u);
            const unsigned tg = og / nx;
            if (og + 1u == (tg + 1u) * nx) xb_add(&bar[XB_TOPGEN], 1u);
            else XB_SPIN(xb_ld(&bar[XB_TOPGEN]) == tg, bar);
            __builtin_amdgcn_fence(__ATOMIC_ACQUIRE, "agent");
            xb_add(&bar[XB_XGEN(b.x)], 1u);
            asm volatile("s_waitcnt vmcnt(0)" ::: "memory");
        } else {
            XB_SPIN(xb_ld(&bar[XB_XGEN(b.x)]) == gen, bar);
            __builtin_amdgcn_fence(__ATOMIC_ACQUIRE, "agent");
            asm volatile("s_waitcnt vmcnt(0)" ::: "memory");
        }
    }
    __syncthreads();
}

struct Frame {
    LAS unsigned char* lds;
    volatile LAS unsigned* MISC;
    gu32* ctl;
    int tid, lane, wave;
    int vcu, G;
    const float *x, *w_in, *mu_prev, *mu_next, *w0, *w2, *a0, *a2, *g2, *k_k, *k_a, *r_k, *lnx_w, *lnx_b, *qnw, *knw, *w_out, *norm1_w, *norm2_w, *w_pq, *sub_keys, *u_tab, *v_tab, *normf_w;
    float* out;
    bf16 *WinT, *WoutT, *WsT, *w2T, *a2T, *g2T, *H1; float* INVR;
    bf16 *H, *P, *AR, *G16, *U16, *V16;
    float *Y, *ROPE, *S;
    unsigned char *U8, *V8; float *US, *VS;
};

__device__ __forceinline__ void p0_transpose_item(const float* W, int K, int N, bf16* WT, LAS float* scr, int item, int lane) {
    const int nblk = N / 32, kb = item / nblk, nb = item % nblk, k0 = 64 * kb, n0 = 32 * nb;
    float tv[32];
#pragma unroll
    for (int i = 0; i < 32; ++i) tv[i] = __builtin_nontemporal_load(&W[(size_t)(k0 + 2 * i + (lane >> 5)) * N + n0 + (lane & 31)]);
#pragma unroll
    for (int i = 0; i < 32; ++i) scr[(2 * i + (lane >> 5)) * 33 + (lane & 31)] = tv[i];
    LDS_WAIT(); asm volatile("" ::: "memory");
    const int c = lane & 7;
#pragma unroll
    for (int j = 0; j < 4; ++j) { const int n = (lane >> 3) + 8 * j; const LAS float* s = scr + (8 * c) * 33 + n;
        v4u o; o.x = pk2c(s[0 * 33], s[1 * 33]); o.y = pk2c(s[2 * 33], s[3 * 33]); o.z = pk2c(s[4 * 33], s[5 * 33]); o.w = pk2c(s[6 * 33], s[7 * 33]);
        *(GAS v4u*)(WT + (size_t)(n0 + n) * K + k0 + 8 * c) = o; }
    LDS_WAIT(); asm volatile("" ::: "memory");
}
__device__ __forceinline__ void rms_row_to_bf16(int lane, const float* xrow, const float* w, bf16* orow) {
    const GAS f32x4* xr = (const GAS f32x4*)xrow + lane;
    f32x4 v[8]; float s = 0.f;
#pragma unroll
    for (int j = 0; j < 8; ++j) { v[j] = xr[64 * j]; s += (v[j].x * v[j].x + v[j].y * v[j].y) + (v[j].z * v[j].z + v[j].w * v[j].w); }
    const float rstd = 1.0f / sqrtf(wave_sum(s) * (1.f / DMODEL) + 1e-6f);
    const GAS f32x4* wr = (const GAS f32x4*)w + lane;
    GAS v2u* o8 = (GAS v2u*)orow + lane;
#pragma unroll
    for (int j = 0; j < 8; ++j) { const f32x4 wv = wr[64 * j]; v2u o; o.x = pk2c(v[j].x * rstd * wv.x, v[j].y * rstd * wv.y); o.y = pk2c(v[j].z * rstd * wv.z, v[j].w * rstd * wv.w); o8[64 * j] = o; }
}
__device__ __forceinline__ void sincos_d(double x, double& s, double& c) {
    const double TWO_PI = 6.283185307179586476925286766559;
    const double k = __builtin_rint(x / TWO_PI); const double r = x - k * TWO_PI, r2 = r * r;
    double ts = r, tc = 1.0; s = r; c = 1.0;
    for (int n = 1; n <= 14; ++n) { tc *= -r2 / (double)((2 * n - 1) * (2 * n)); ts *= -r2 / (double)((2 * n) * (2 * n + 1)); c += tc; s += ts; }
}
__device__ __forceinline__ void rms_2rows_to_bf16(int lane, const float* x0, const float* x1, const float* w, bf16* o0, bf16* o1, float* inv2) {
    const GAS f32x4* xr0 = (const GAS f32x4*)x0 + lane; const GAS f32x4* xr1 = (const GAS f32x4*)x1 + lane;
    f32x4 v0[8], v1[8]; float s0 = 0.f, s1 = 0.f;
#pragma unroll
    for (int j = 0; j < 8; ++j) { v0[j] = __builtin_nontemporal_load(&xr0[64 * j]); v1[j] = __builtin_nontemporal_load(&xr1[64 * j]); }
#pragma unroll
    for (int j = 0; j < 8; ++j) { s0 += (v0[j].x * v0[j].x + v0[j].y * v0[j].y) + (v0[j].z * v0[j].z + v0[j].w * v0[j].w); s1 += (v1[j].x * v1[j].x + v1[j].y * v1[j].y) + (v1[j].z * v1[j].z + v1[j].w * v1[j].w); }
    const float i0 = sqrtf(wave_sum(s0) * (1.f / DMODEL) + 1e-6f), i1 = sqrtf(wave_sum(s1) * (1.f / DMODEL) + 1e-6f); const float r0 = 1.0f / i0, r1 = 1.0f / i1;
    if (lane == 0) *(f32x2*)inv2 = (f32x2){i0, i1};
    const GAS f32x4* wr = (const GAS f32x4*)w + lane;
    GAS v2u* p0 = (GAS v2u*)o0 + lane; GAS v2u* p1 = (GAS v2u*)o1 + lane;
#pragma unroll
    for (int j = 0; j < 8; ++j) { const f32x4 wv = wr[64 * j];
        p0[64 * j] = (v2u){pk2c(v0[j].x * r0 * wv.x, v0[j].y * r0 * wv.y), pk2c(v0[j].z * r0 * wv.z, v0[j].w * r0 * wv.w)};
        p1[64 * j] = (v2u){pk2c(v1[j].x * r1 * wv.x, v1[j].y * r1 * wv.y), pk2c(v1[j].z * r1 * wv.z, v1[j].w * r1 * wv.w)}; }
}
__device__ __forceinline__ void p0_prologue(Frame& F) {
    if (F.wave < 4) {
        const int aw = F.vcu * 4 + F.wave, NAW = F.G * 4;
        for (int m = 2 * aw; m < T_TOK; m += 2 * NAW) rms_2rows_to_bf16(F.lane, F.x + (size_t)m * DMODEL, F.x + (size_t)(m + 1) * DMODEL, F.norm1_w, F.H1 + (size_t)m * DMODEL, F.H1 + (size_t)(m + 1) * DMODEL, F.INVR + m);
        return;
    }
    LAS float* scr = (LAS float*)(F.lds + F.wave * 16384);
    const int gw = F.vcu * 4 + (F.wave - 4), NGW = F.G * 4;
    const int gtid = gw * 64 + F.lane, NT = NGW * 64;
    constexpr int I_IN = (2048 / 64) * (5248 / 32), I_OUT = (2048 / 64) * (2048 / 32);
    for (int it = gw; it < I_IN + I_OUT; it += NGW) {
        if (it < I_IN) p0_transpose_item(F.w_in, 2048, 5248, F.WinT, scr, it, F.lane);
        else p0_transpose_item(F.w_out, 2048, 2048, F.WoutT, scr, it - I_IN, F.lane);
    }
    for (int i = gtid; i < 128 * 2048 / 8; i += NT) ((GAS v4u*)(F.WinT + (size_t)5248 * 2048))[i] = (v4u){0u, 0u, 0u, 0u};
    for (int i = gtid; i < 4 * 96 * 1024; i += NT) { const int c = i & 1023, ml = i >> 10, mat = ml / 96, l = ml - mat * 96;
        const float v = (mat < 2 ? F.w2 : F.a2)[(size_t)((mat & 1) * 96 + l) * 1024 + c];
        F.w2T[(size_t)(((mat * 32 + (c >> 5)) * 6 + (l >> 4)) * 512) + ((((l >> 3) & 1) * 32 + (c & 31)) * 8) + (l & 7)] = (bf16)f2bf(v); }
    for (int i = gtid; i < 256 * 1024; i += NT) { const int c = i & 1023, l = i >> 10;
        F.g2T[(size_t)((((c >> 5) * 16 + (l >> 4)) * 512)) + ((((l >> 3) & 1) * 32 + (c & 31)) * 8) + (l & 7)] = (bf16)f2bf(F.g2[i]); }
    for (int i = gtid; i < 1024; i += NT) { double s, c; sincos_d((double)(i >> 4) * kRopeInv[i & 15], s, c); F.ROPE[2 * i] = (float)c; F.ROPE[2 * i + 1] = (float)s; }
    for (int tile = gw; tile < 4096; tile += NGW) {
        const int hp = tile >> 8, nt = (tile >> 6) & 3, dt = tile & 63, c32 = F.lane & 31, hi = F.lane >> 5;
        const GAS f32x4* ka = (const GAS f32x4*)(F.sub_keys + (size_t)(hp * 128 + nt * 32 + c32) * 128 + hi * 8);
        const GAS f32x4* wb = (const GAS f32x4*)(F.w_pq + (size_t)(dt * 32 + c32) * 2048 + hp * 128 + hi * 8);
        f32x16 acc;
#pragma unroll
        for (int r = 0; r < 16; ++r) acc[r] = 0.f;
#pragma unroll 1
        for (int kh = 0; kh < 2; ++kh) {
            f32x4 av[8], bv[8];
#pragma unroll
            for (int ks = 0; ks < 4; ++ks) { av[2 * ks] = ka[16 * kh + 4 * ks]; av[2 * ks + 1] = ka[16 * kh + 4 * ks + 1]; bv[2 * ks] = wb[16 * kh + 4 * ks]; bv[2 * ks + 1] = wb[16 * kh + 4 * ks + 1]; }
#pragma unroll
            for (int ks = 0; ks < 4; ++ks) {
                const f32x4 a0 = av[2 * ks], a1 = av[2 * ks + 1], b0 = bv[2 * ks], b1 = bv[2 * ks + 1];
                const v4u ah = (v4u){pk2c(a0.x, a0.y), pk2c(a0.z, a0.w), pk2c(a1.x, a1.y), pk2c(a1.z, a1.w)}, bh = (v4u){pk2c(b0.x, b0.y), pk2c(b0.z, b0.w), pk2c(b1.x, b1.y), pk2c(b1.z, b1.w)};
                const v4u al = (v4u){pk2c(a0.x - bflo(ah.x), a0.y - bfhi(ah.x)), pk2c(a0.z - bflo(ah.y), a0.w - bfhi(ah.y)), pk2c(a1.x - bflo(ah.z), a1.y - bfhi(ah.z)), pk2c(a1.z - bflo(ah.w), a1.w - bfhi(ah.w))};
                const v4u bl = (v4u){pk2c(b0.x - bflo(bh.x), b0.y - bfhi(bh.x)), pk2c(b0.z - bflo(bh.y), b0.w - bfhi(bh.y)), pk2c(b1.x - bflo(bh.z), b1.y - bfhi(bh.z)), pk2c(b1.z - bflo(bh.w), b1.w - bfhi(bh.w))};
                acc = __builtin_amdgcn_mfma_f32_32x32x16_bf16(__builtin_bit_cast(bf16x8, ah), __builtin_bit_cast(bf16x8, bh), acc, 0, 0, 0);
                acc = __builtin_amdgcn_mfma_f32_32x32x16_bf16(__builtin_bit_cast(bf16x8, ah), __builtin_bit_cast(bf16x8, bl), acc, 0, 0, 0);
                acc = __builtin_amdgcn_mfma_f32_32x32x16_bf16(__builtin_bit_cast(bf16x8, al), __builtin_bit_cast(bf16x8, bh), acc, 0, 0, 0);
            }
        }
        bf16* op = F.WsT + (size_t)(hp * 128 + nt * 32 + 4 * hi) * 2048 + dt * 32 + c32;
        const float w2d = F.norm2_w[dt * 32 + c32];
#pragma unroll
        for (int r = 0; r < 16; ++r) op[(size_t)((r & 3) + 8 * (r >> 2)) * 2048] = (bf16)pk2c(acc[r] * w2d, 0.f);
    }
}

__device__ __forceinline__ float shifted(const bf16* P, size_t row, int t, int col, float mp, float mn) {
    const bf16* p = P + row * PC + col;
    const float z = bf2f(p[0]);
    const float zp = (t > 0) ? bf2f(*(p - PC)) : 0.f;
    const float zn = (t < SEQL - 1) ? bf2f(p[PC]) : 0.f;
    return z + mp * (zp - z) + mn * (zn - z);
}

template <bool QKPREP> __device__ __forceinline__ void p2_prep(Frame& F) {
    LAS bf16* At = (LAS bf16*)F.lds;
    LAS bf16* Raw = (LAS bf16*)(F.lds + 41472);
    const int lane = F.lane, wave = F.wave, c32 = lane & 31, hi = lane >> 5;
    bf16* EW = F.H;
    for (int u = blockIdx.x; u < T_TOK / 32; u += F.G) {
        const int row0 = u * 32;
        for (int i = 0; i < 6; ++i) { const int item = F.tid + 512 * i;
            if (item < 34 * 80) { const int rr = item / 80, seg = item - rr * 80; const int row = row0 - 1 + rr;
                const bool ok = !((rr == 0 && (row0 & (SEQL - 1)) == 0) || (rr == 33 && ((row0 + 32) & (SEQL - 1)) == 0));
                v4u v = (v4u){0u, 0u, 0u, 0u};
                if (ok) v = __builtin_nontemporal_load((const GAS v4u*)(F.P + (size_t)row * PC + COL_LORA + seg * 8));
                *(LAS v4u*)(Raw + rr * 640 + seg * 8) = v; } }
        __syncthreads();
        for (int i = 0; i < 5; ++i) { const int item = F.tid + 512 * i, tok = item / 80, seg = item - tok * 80;
            const v4u z4 = *(const LAS v4u*)(Raw + (tok + 1) * 640 + seg * 8), p4 = *(const LAS v4u*)(Raw + tok * 640 + seg * 8), n4 = *(const LAS v4u*)(Raw + (tok + 2) * 640 + seg * 8);
            const f32x4 mpa = *(const f32x4*)(F.mu_prev + COL_LORA + seg * 8), mpb = *(const f32x4*)(F.mu_prev + COL_LORA + seg * 8 + 4), mna = *(const f32x4*)(F.mu_next + COL_LORA + seg * 8), mnb = *(const f32x4*)(F.mu_next + COL_LORA + seg * 8 + 4);
            float a[8];
#pragma unroll
            for (int j = 0; j < 8; ++j) { const unsigned zw = z4[j >> 1], pw = p4[j >> 1], nw = n4[j >> 1];
                const float z = (j & 1) ? bfhi(zw) : bflo(zw), zp = (j & 1) ? bfhi(pw) : bflo(pw), zn = (j & 1) ? bfhi(nw) : bflo(nw);
                const float mp = j < 4 ? mpa[j & 3] : mpb[j & 3], mn = j < 4 ? mna[j & 3] : mnb[j & 3];
                const float zs = z + mp * (zp - z) + mn * (zn - z);
                a[j] = seg < 24 ? tanh_f(zs) : (seg < 48 ? zs : sigmoid_f(zs)); }
            *(LAS v4u*)(At + tok * 648 + seg * 8) = (v4u){pk2c(a[0], a[1]), pk2c(a[2], a[3]), pk2c(a[4], a[5]), pk2c(a[6], a[7])}; }
        __syncthreads();
        LAS unsigned char* Ot = F.lds + 41472 + wave * 8704;
#define P2_WLOAD96(wf, b_) do { const bf16* wp_ = F.w2T + (size_t)((((b_) >> 2) * 32 + wave * 4 + ((b_) & 3)) * 6) * 512 + lane * 8; \
            _Pragma("unroll") for (int ks = 0; ks < 6; ++ks) wf[ks] = *(const bf16x8*)(wp_ + ks * 512); } while (0)
#define P2_MMA96(wf, acc, b_) do { _Pragma("unroll") for (int r = 0; r < 16; ++r) acc[r] = 0.f; \
            const LAS bf16* ap = At + c32 * 648 + ((b_) >> 2) * 96 + hi * 8; \
            _Pragma("unroll") for (int ks = 0; ks < 6; ++ks) acc = __builtin_amdgcn_mfma_f32_32x32x16_bf16(wf[ks], *(const LAS bf16x8*)(ap + ks * 16), acc, 0, 0, 0); } while (0)
#define P2_BIAS96(bvv, b_) do { const int mat = (b_) >> 2, ch0 = wave * 128 + ((b_) & 3) * 32 + 4 * hi; const float* bp = (mat < 2 ? F.w0 + mat * 1024 : F.a0 + (mat - 2) * 1024) + ch0; \
            _Pragma("unroll") for (int r4 = 0; r4 < 4; ++r4) bvv[r4] = *(const f32x4*)(bp + 8 * r4); } while (0)
#define P2_EPI96(acc, bvv, b_) do { const int mat = (b_) >> 2; const float sc = mat < 2 ? 0.6065306597126334f : 1.0f; \
            LAS unsigned char* tp = Ot + c32 * 272 + ((b_) & 3) * 64 + 8 * hi; \
            _Pragma("unroll") for (int r4 = 0; r4 < 4; ++r4) { const f32x4 bv = bvv[r4]; \
                const float o0 = sc * sigmoid_f(acc[4 * r4] + bv.x), o1 = sc * sigmoid_f(acc[4 * r4 + 1] + bv.y), o2 = sc * sigmoid_f(acc[4 * r4 + 2] + bv.z), o3 = sc * sigmoid_f(acc[4 * r4 + 3] + bv.w); \
                *(LAS v2u*)(tp + 16 * r4) = (v2u){pk2c(o0, o1), pk2c(o2, o3)}; } \
            if (((b_) & 3) == 3) { LDS_WAIT(); bf16* dp = (mat < 2 ? EW + (size_t)mat * T_TOK * 1024 : F.AR + (size_t)(mat - 2) * T_TOK * 1024) + (size_t)row0 * 1024 + wave * 128 + (lane & 15) * 8; \
                _Pragma("unroll") for (int i8 = 0; i8 < 8; ++i8) { const int rw_ = (lane >> 4) + 4 * i8; *(GAS v4u*)(dp + (size_t)rw_ * 1024) = *(const LAS v4u*)(Ot + rw_ * 272 + (lane & 15) * 16); } \
                LDS_WAIT(); } } while (0)
        { bf16x8 wa[6]; f32x16 acc; f32x4 bvv[4];
          P2_WLOAD96(wa, 0);
#pragma unroll 1
          for (int b = 0; b < 16; ++b) { P2_BIAS96(bvv, b); asm volatile("" ::: "memory"); P2_MMA96(wa, acc, b); asm volatile("" : "+v"(acc)); if (b + 1 < 16) P2_WLOAD96(wa, b + 1); asm volatile("" ::: "memory"); P2_EPI96(acc, bvv, b); } }
#undef P2_BIAS96
#undef P2_WLOAD96
#undef P2_MMA96
#undef P2_EPI96
#define P2_WLOADG(wf, cb_) do { const bf16* wp_ = F.g2T + (size_t)((wave * 4 + (cb_)) * 16) * 512 + lane * 8; \
            _Pragma("unroll") for (int ks = 0; ks < 16; ++ks) wf[ks] = *(const bf16x8*)(wp_ + ks * 512); } while (0)
        { bf16x8 ga[16]; f32x16 acc;
          P2_WLOADG(ga, 0);
#pragma unroll 1
          for (int cb = 0; cb < 4; ++cb) {
#pragma unroll
              for (int r = 0; r < 16; ++r) acc[r] = 0.f;
              const LAS bf16* ap = At + c32 * 648 + 384 + hi * 8;
#pragma unroll
              for (int ks = 0; ks < 16; ++ks) acc = __builtin_amdgcn_mfma_f32_32x32x16_bf16(ga[ks], *(const LAS bf16x8*)(ap + ks * 16), acc, 0, 0, 0);
              asm volatile("" : "+v"(acc));
              if (cb + 1 < 4) P2_WLOADG(ga, cb + 1);
              { LAS unsigned char* tp = Ot + c32 * 272 + cb * 64 + 8 * hi;
#pragma unroll
                for (int r4 = 0; r4 < 4; ++r4) *(LAS v2u*)(tp + 16 * r4) = (v2u){pk2c(acc[4 * r4], acc[4 * r4 + 1]), pk2c(acc[4 * r4 + 2], acc[4 * r4 + 3])}; }
              if (cb == 3) { LDS_WAIT(); bf16* dp = F.G16 + (size_t)row0 * 1024 + wave * 128 + (lane & 15) * 8;
#pragma unroll
                for (int i8 = 0; i8 < 8; ++i8) { const int rw_ = (lane >> 4) + 4 * i8; *(GAS v4u*)(dp + (size_t)rw_ * 1024) = *(const LAS v4u*)(Ot + rw_ * 272 + (lane & 15) * 16); }
                LDS_WAIT(); } } }
#undef P2_WLOADG
        if (QKPREP) for (int ib = 0; ib < 4; ++ib) {
            const int li = lane & 15;
            bf16* pp[5]; v2u xw[5]; f32x4 cs0[5], cs1[5]; int hq[5];
#pragma unroll
            for (int u5 = 0; u5 < 5; ++u5) { const int it4 = wave + NWAVES * (5 * ib + u5);
                const int item = it4 * 4 + (lane >> 4), tok = item / 20, hh = item - tok * 20;
                const size_t row = (size_t)(row0 + tok); const int t = (int)(row & (SEQL - 1));
                pp[u5] = F.P + row * PC + (hh < 16 ? COL_Q + hh * 64 : COL_KA + (hh - 16) * 64) + 4 * li; hq[u5] = hh;
                xw[u5] = *(const GAS v2u*)pp[u5];
                const int pos = (li < 8) ? (t >> 6) : (t & 63);
                cs0[u5] = *(const f32x4*)(F.ROPE + 2 * (pos * 16 + 4 * (li & 3))); cs1[u5] = *(const f32x4*)(F.ROPE + 2 * (pos * 16 + 4 * (li & 3)) + 4); }
            const f32x4 wq = *(const f32x4*)(F.qnw + 4 * li), wk = *(const f32x4*)(F.knw + 4 * li);
            v2u ow[5];
#pragma unroll
            for (int u5 = 0; u5 < 5; ++u5) {
                const f32x4 xv = (f32x4){bflo(xw[u5].x), bfhi(xw[u5].x), bflo(xw[u5].y), bfhi(xw[u5].y)};
                const float ss = allred16((xv.x * xv.x + xv.y * xv.y) + (xv.z * xv.z + xv.w * xv.w));
                const float rstd = __builtin_amdgcn_rsqf(ss * (1.f / 64.f) + 1e-6f);
                const f32x4 xn = xv * rstd * (hq[u5] < 16 ? wq : wk);
                f32x4 pr;
#pragma unroll
                for (int j = 0; j < 4; ++j) { const float up = dppf<0x104>(xn[j]), dn = dppf<0x114>(xn[j]); pr[j] = (li & 4) ? dn : up; }
                const f32x4 cc = (f32x4){cs0[u5].x, cs0[u5].z, cs1[u5].x, cs1[u5].z}, sn = (f32x4){cs0[u5].y, cs0[u5].w, cs1[u5].y, cs1[u5].w};
                f32x4 o = (li & 4) ? (xn * cc + pr * sn) : (xn * cc - pr * sn);
                if (hq[u5] < 16) o = o * attn_body::C2;
                ow[u5] = (v2u){pk2c(o.x, o.y), pk2c(o.z, o.w)}; }
#pragma unroll
            for (int u5 = 0; u5 < 5; ++u5) *(GAS v2u*)pp[u5] = ow[u5];
        }
        __syncthreads();
    }
}

__device__ __forceinline__ bf16x8 pack4z(f32x4 v) { const unsigned a = pk2c(v.x, v.y), b = pk2c(v.z, v.w); const v4u w = (v4u){a, b, 0u, 0u}; return __builtin_bit_cast(bf16x8, w); }
__device__ __forceinline__ bf16x8 ld8z(const LAS unsigned char* p) { const v2u a = *(const LAS v2u*)p; const v4u w = (v4u){a.x, a.y, 0u, 0u}; return __builtin_bit_cast(bf16x8, w); }
__device__ __forceinline__ bf16x8 ld16(const LAS unsigned char* p) { return *(const LAS bf16x8*)p; }
typedef short s16x4_t __attribute__((ext_vector_type(4)));
__device__ __forceinline__ void glds16s_nt(const void* gsrc, unsigned lds_dst) { unsigned keep;
    asm volatile("s_mov_b32 %0, m0\n\ts_mov_b32 m0, %2\n\ts_nop 0\n\tglobal_load_lds_dwordx4 %1, off nt\n\ts_mov_b32 m0, %0" : "=&s"(keep) : "v"(gsrc), "s"(lds_dst) : "memory"); }
__device__ __forceinline__ void glds16s(const void* gsrc, unsigned lds_dst) { unsigned keep;
    asm volatile("s_mov_b32 %0, m0\n\ts_mov_b32 m0, %2\n\ts_nop 0\n\tglobal_load_lds_dwordx4 %1, off\n\ts_mov_b32 m0, %0" : "=&s"(keep) : "v"(gsrc), "s"(lds_dst) : "memory"); }
__device__ __forceinline__ v2u vtr2(const LAS unsigned char* p) { return __builtin_bit_cast(v2u, __builtin_amdgcn_ds_read_tr16_b64_v4i16((LAS s16x4_t*)p)); }
__device__ __forceinline__ void tab_load(const Frame& F, int r, int lane, f32x4 (&v)[8]) {
    const int tb = r >> 14, row = r & 16383;
    const GAS f32x4* src = (const GAS f32x4*)((tb ? F.v_tab : F.u_tab) + (size_t)row * 2048) + lane;
#pragma unroll
    for (int j = 0; j < 8; ++j) v[j] = __builtin_nontemporal_load(&src[64 * j]);
}
__device__ __forceinline__ void tab_finish(const Frame& F, int r, int lane, const f32x4 (&v)[8]) {
    const int tb = r >> 14, row = r & 16383;
    float am = 0.f;
#pragma unroll
    for (int j = 0; j < 8; ++j) am = fmaxf(fmaxf(am, fmaxf(fabsf(v[j].x), fabsf(v[j].y))), fmaxf(fabsf(v[j].z), fabsf(v[j].w)));
    am = wave_max(am);
    const unsigned ab = __float_as_uint(am * (1.0f / 7.5f));
    const float sc = am > 0.f ? __uint_as_float((ab + 0x7FFFFFu) & 0x7F800000u) : 1.0f;
    f32x16 x, y;
#pragma unroll
    for (int j = 0; j < 8; ++j) { x[2 * j] = v[j].x; y[2 * j] = v[j].y; x[2 * j + 1] = v[j].z; y[2 * j + 1] = v[j].w; }
    const v6u p = __builtin_amdgcn_cvt_scalef32_2xpk16_fp6_f32(x, y, sc);
    unsigned char* drow = (tb ? F.V8 : F.U8) + (size_t)row * 1536;
    __builtin_nontemporal_store((v4u){p[0], p[1], p[2], p[3]}, (GAS v4u*)(drow + lane * 16)); __builtin_nontemporal_store((v2u){p[4], p[5]}, (GAS v2u*)(drow + 1024 + lane * 8));
    if (lane == 0) (tb ? F.VS : F.US)[row] = sc;
}
struct Conv2C { f32x2 mp_r, mn_r, mp_k, mn_k, mp_v, mn_v, kkw, kaw; };
template <int PAIRIDX> __device__ __forceinline__ void scan_convert2(const LAS unsigned char* rawp, LAS unsigned char* Mn, int dir, int lane, const Conv2C& K) {
    constexpr int CS = 16, S0 = 2 * PAIRIDX;
    const int half = lane >> 5, cp = lane & 31, s = S0 + half;
    const LAS unsigned* rw = (const LAS unsigned*)rawp + cp;
    unsigned pe[S0 > 0 ? S0 : 1];
#pragma unroll
    for (int sp = 0; sp < S0; ++sp) { const int rr0 = dir ? (CS - sp) : (sp + 1); pe[sp] = rw[(54 + rr0 - 1) * 32]; }
    const int rr = dir ? (CS - s) : (s + 1);
    const int rrE = dir ? (CS - S0) : (S0 + 1);
    const unsigned r0w = rw[rr * 32], rpw = rw[(rr - 1) * 32], rnw = rw[(rr + 1) * 32];
    const unsigned k0w = rw[(18 + rr) * 32], kpw = rw[(18 + rr - 1) * 32], knw = rw[(18 + rr + 1) * 32];
    const unsigned v0w = rw[(36 + rr) * 32], vpw = rw[(36 + rr - 1) * 32], vnw = rw[(36 + rr + 1) * 32];
    const unsigned eww = rw[(54 + rr - 1) * 32], eEw = rw[(54 + rrE - 1) * 32], aaw = rw[(70 + rr - 1) * 32];
    float cum0 = 0.f, cum1 = 0.f;
#pragma unroll
    for (int sp = 0; sp < S0; ++sp) { cum0 += bflo(pe[sp]); cum1 += bfhi(pe[sp]); }
    if (half) { cum0 += bflo(eEw); cum1 += bfhi(eEw); }
    const f32x2 r0 = {bflo(r0w), bfhi(r0w)}, rp = {bflo(rpw), bfhi(rpw)}, rn = {bflo(rnw), bfhi(rnw)};
    const f32x2 k0 = {bflo(k0w), bfhi(k0w)}, kp = {bflo(kpw), bfhi(kpw)}, kn = {bflo(knw), bfhi(knw)};
    const f32x2 v0 = {bflo(v0w), bfhi(v0w)}, vp = {bflo(vpw), bfhi(vpw)}, vn = {bflo(vnw), bfhi(vnw)};
    const f32x2 rs = r0 + K.mp_r * (rp - r0) + K.mn_r * (rn - r0), kx = k0 + K.mp_k * (kp - k0) + K.mn_k * (kn - k0), vv = v0 + K.mp_v * (vp - v0) + K.mn_v * (vn - v0);
    const f32x2 kkr = kx * K.kkw;
    float n2 = kkr.x * kkr.x + kkr.y * kkr.y;
    n2 = allred16(n2);
    { const auto r16 = __builtin_amdgcn_permlane16_swap(__float_as_uint(n2), __float_as_uint(n2), false, false); n2 = __uint_as_float(r16[0]) + __uint_as_float(r16[1]); }
    const float rn2 = __builtin_amdgcn_rsqf(fmaxf(n2, 1e-24f));
    const f32x2 kk = kkr * rn2, ew = {bflo(eww), bfhi(eww)}, aa = {bflo(aaw), bfhi(aaw)};
    const f32x2 cA = {cum0, cum1}, cB = cA + ew;
    f32x2 Lp, Lt, Li; Lp.x = __expf(-cA.x); Lp.y = __expf(-cA.y); Lt.x = __expf(-cB.x); Lt.y = __expf(-cB.y); Li.x = __expf(cB.x); Li.y = __expf(cB.y);
    const f32x2 av = Lp * kk, bv = kk * aa * Li, cv = kx * ((aa - 1.0f) * K.kaw + 1.0f) * Li, qv = rs * Lt;
    const unsigned aw_ = pk2c(av.x, av.y), bw_ = pk2c(bv.x, bv.y), cw_ = pk2c(cv.x, cv.y), qw_ = pk2c(qv.x, qv.y), vw_ = pk2c(vv.x, vv.y);
    LAS unsigned* m32 = (LAS unsigned*)Mn + cp;
    m32[0 * 576 + s * 36] = aw_; m32[1 * 576 + s * 36] = bw_; m32[2 * 576 + s * 36] = cw_; m32[3 * 576 + s * 36] = qw_;
    m32[4 * 576 + s * 36] = vw_;
    if (s == CS - 1) *(LAS f32x2*)((LAS float*)(Mn + 11520) + 2 * cp) = Lt;
}
__device__ __forceinline__ void p3_scan(Frame& F) {
    constexpr int CS = 16, NC = SEQL / CS;
    constexpr int MP = 144;
    constexpr int PAR = 11776;
    constexpr int O_SB = 3 * PAR;
    constexpr int O_SM = O_SB + 9216;
    constexpr int O_NF = O_SM + 4096;
    constexpr int O_YB = O_NF + 1024;
    constexpr int O_RAW = O_YB + 8192;
    constexpr int RAWB = (3 * 18 + 16 + 16) * 128;
    static_assert(O_RAW + 4 * RAWB <= 131072, "scan LDS");
    LAS unsigned char* L = F.lds;
    const int lane = F.lane, w = F.wave, g = lane >> 4, c = lane & 15, tid = F.tid;
    for (int chain = blockIdx.x; chain < 256; chain += F.G) {
        const int dir = chain >> 7, b = (chain >> 4) & 7, h = chain & 15;
        const int ch = h * 64 + lane;
        const float mp_r = F.mu_prev[ch], mn_r = F.mu_next[ch], mp_k = F.mu_prev[1024 + ch], mn_k = F.mu_next[1024 + ch], mp_v = F.mu_prev[2048 + ch], mn_v = F.mu_next[2048 + ch];
        const float kkw = F.k_k[ch], kaw = F.k_a[ch];
        Conv2C K2; { const int c2 = h * 64 + 2 * (lane & 31);
            K2.mp_r = *(const f32x2*)(F.mu_prev + c2); K2.mn_r = *(const f32x2*)(F.mu_next + c2); K2.mp_k = *(const f32x2*)(F.mu_prev + 1024 + c2); K2.mn_k = *(const f32x2*)(F.mu_next + 1024 + c2);
            K2.mp_v = *(const f32x2*)(F.mu_prev + 2048 + c2); K2.mn_v = *(const f32x2*)(F.mu_next + 2048 + c2); K2.kkw = *(const f32x2*)(F.k_k + c2); K2.kaw = *(const f32x2*)(F.k_a + c2); }
        const bf16* EWd = F.H + (size_t)dir * T_TOK * 1024 + (size_t)b * SEQL * 1024 + h * 64;
        const bf16* ARd = F.AR + (size_t)dir * T_TOK * 1024 + (size_t)b * SEQL * 1024 + h * 64;
        const bf16* Pb = F.P + (size_t)b * SEQL * PC + h * 64;
        const bf16* l_ptr[2]; int l_t[2]; int l_step[2]; bool l_on[2], l_chk[2]; unsigned l_dst[2];
#pragma unroll
        for (int sl = 0; sl < 2; ++sl) { const int item = sl == 0 ? tid : ((lane < 22) ? 512 + 22 * w + lane : 1 << 20); const int tlo0 = dir ? (SEQL - CS) : 0;
            l_dst[sl] = (unsigned)item * 16u;
            if (item < 432) { const int arr = item / 144, rem = item - arr * 144, rr = rem >> 3, seg = rem & 7; l_on[sl] = true; l_chk[sl] = true; l_t[sl] = tlo0 - 1 + rr;
                l_ptr[sl] = Pb + (ptrdiff_t)(tlo0 - 1 + rr) * PC + arr * 1024 + seg * 8; l_step[sl] = (dir ? -CS : CS) * PC; }
            else if (item < 688) { const int k2 = item >= 560, rem = item - (k2 ? 560 : 432), rr = rem >> 3, seg = rem & 7; l_on[sl] = true; l_chk[sl] = false; l_t[sl] = 0;
                l_ptr[sl] = (k2 ? ARd : EWd) + (ptrdiff_t)(tlo0 + rr) * 1024 + seg * 8; l_step[sl] = (dir ? -CS : CS) * 1024; }
            else { l_on[sl] = false; l_chk[sl] = false; l_t[sl] = 0; l_ptr[sl] = Pb; l_step[sl] = 0; } }
        const unsigned dma0 = (unsigned)(size_t)(L + O_RAW) + (unsigned)(w * 64) * 16u, dma1 = (unsigned)(size_t)(L + O_RAW) + (unsigned)(512 + 22 * w) * 16u;
        f32x4 st[4]; st[0] = (f32x4){0.f, 0.f, 0.f, 0.f}; st[1] = st[0]; st[2] = st[0]; st[3] = st[0];
        __syncthreads();
        for (int i = tid; i < 9216 / 4; i += 512) ((LAS unsigned*)(L + O_SB))[i] = 0u;
        for (int ci = -4; ci < NC; ++ci) {
            LAS unsigned char* M = L + ((ci + 6) % 3) * PAR;
            LAS unsigned char* SMc = L + O_SM + (ci & 1) * 2048;
            v2u yv = (v2u){0u, 0u}; GAS v2u* yp = nullptr;
            if (ci >= 1 && tid < 256) { const LAS float* yb = (const LAS float*)(L + O_YB + ((ci - 1) & 1) * 4096); const int s = tid >> 4, i4 = (tid & 15) * 4; const int stp = (ci - 1) * CS + s; const int t = dir ? (SEQL - 1 - stp) : stp;
                const f32x4 yf = *(const LAS f32x4*)(yb + s * 64 + i4); yv = (v2u){pk2c(yf.x, yf.y), pk2c(yf.z, yf.w)}; yp = (GAS v2u*)((bf16*)F.Y + ((size_t)dir * T_TOK + (size_t)b * SEQL + t) * 1024 + h * 64 + i4);
                *yp = yv; }
            const int cl = ci + 4; const bool doload = cl < NC;
            if (doload) { const unsigned stg = (unsigned)((cl & 3) * RAWB);
#pragma unroll
                for (int sl = 0; sl < 2; ++sl) {
                    if (l_on[sl]) {
                        if (!l_chk[sl] || (unsigned)l_t[sl] < (unsigned)SEQL) { if (sl) glds16s_nt(l_ptr[sl], dma1 + stg); else glds16s(l_ptr[sl], dma0 + stg); }
                        else *(LAS v4u*)(L + O_RAW + stg + l_dst[sl]) = (v4u){0u, 0u, 0u, 0u}; }
                    l_ptr[sl] += l_step[sl]; l_t[sl] += dir ? -CS : CS; } }
            if (w >= 4) {
                if (ci >= 0) {
                    const int n = w - 4;
                    const LAS float* Lc = (const LAS float*)(M + 11520);
                    const LAS unsigned char* trb = M + (4 * g + (c >> 2)) * MP + (c & 3) * 8;
                    v2u bB[4], bC[4]; f32x4 lc[4];
#pragma unroll
                    for (int jt = 0; jt < 4; ++jt) { bB[jt] = vtr2(trb + 1 * 2304 + 32 * jt); bC[jt] = vtr2(trb + 2 * 2304 + 32 * jt); lc[jt] = *(const LAS f32x4*)(Lc + 16 * jt + 4 * g); }
                    const v2u vtw = vtr2(trb + 4 * 2304 + 32 * n);
                    f32x4 g1t = (f32x4){0.f, 0.f, 0.f, 0.f}, qst = g1t;
                    const LAS unsigned char* Sb = L + O_SB + (16 * n + c) * MP + 16 * g;
#pragma unroll
                    for (int ks = 0; ks < 2; ++ks) { const bf16x8 sv = ld16(Sb + 64 * ks);
                        g1t = __builtin_amdgcn_mfma_f32_16x16x32_bf16(ld16(M + 0 * 2304 + c * MP + 16 * g + 64 * ks), sv, g1t, 0, 0, 0);
                        qst = __builtin_amdgcn_mfma_f32_16x16x32_bf16(ld16(M + 3 * 2304 + c * MP + 16 * g + 64 * ks), sv, qst, 0, 0, 0); }
                    const bf16x8 vt = __builtin_bit_cast(bf16x8, (v4u){vtw.x, vtw.y, 0u, 0u});
                    const f32x4 w1t = __builtin_amdgcn_mfma_f32_16x16x32_bf16(ld8z(SMc + 0 + c * 32 + g * 8), vt, g1t, 0, 0, 0);
                    const f32x4 ut = __builtin_amdgcn_mfma_f32_16x16x32_bf16(ld8z(SMc + 1536 + c * 32 + g * 8), pack4z(w1t), (f32x4){0.f, 0.f, 0.f, 0.f}, 0, 0, 0);
                    f32x4 yt = __builtin_amdgcn_mfma_f32_16x16x32_bf16(ld8z(SMc + 512 + c * 32 + g * 8), pack4z(ut), qst, 0, 0, 0);
                    yt = __builtin_amdgcn_mfma_f32_16x16x32_bf16(ld8z(SMc + 1024 + c * 32 + g * 8), vt, yt, 0, 0, 0);
                    LAS float* yb = (LAS float*)(L + O_YB + (ci & 1) * 4096);
#pragma unroll
                    for (int r = 0; r < 4; ++r) yb[(4 * g + r) * 64 + 16 * n + c] = yt[r];
                    const bf16x8 av = __builtin_bit_cast(bf16x8, (v4u){pk2c(ut.x, ut.y), pk2c(ut.z, ut.w), vtw.x, vtw.y});
#pragma unroll
                    for (int jt = 0; jt < 4; ++jt) {
                        f32x4 ns = __builtin_amdgcn_mfma_f32_16x16x32_bf16(__builtin_bit_cast(bf16x8, (v4u){bB[jt].x, bB[jt].y, bC[jt].x, bC[jt].y}), av, st[jt], 0, 0, 0);
                        ns = ns * lc[jt]; st[jt] = ns;
                        *(LAS v2u*)(L + O_SB + (16 * n + c) * MP + (16 * jt + 4 * g) * 2) = (v2u){pk2c(ns.x, ns.y), pk2c(ns.z, ns.w)}; }
                }
            } else if (ci + 1 >= 0 && ci + 1 < NC) {
                const LAS unsigned char* Mg = L + ((ci + 4) % 3) * PAR;
                LAS unsigned char* SMn = L + O_SM + ((ci + 1) & 1) * 2048;
                const LAS unsigned char* Lm = Mg + ((w & 1) ? 2 : 1) * 2304;
                const LAS unsigned char* Rm = Mg + ((w & 2) ? 3 : 0) * 2304;
                f32x4 x = (f32x4){0.f, 0.f, 0.f, 0.f};
#pragma unroll
                for (int ks = 0; ks < 2; ++ks) x = __builtin_amdgcn_mfma_f32_16x16x32_bf16(ld16(Lm + c * MP + 16 * g + 64 * ks), ld16(Rm + c * MP + 16 * g + 64 * ks), x, 0, 0, 0);
#pragma unroll
                for (int r = 0; r < 4; ++r) { const int tau = 4 * g + r; const bool keep = (w < 2) ? (tau < c) : (tau <= c); x[r] = keep ? x[r] : 0.f; }
                if (w == 0) {
#if SCAN_INV_MFMA
#define MM(Z, Y) __builtin_amdgcn_mfma_f32_16x16x32_bf16(pack4z(Z), pack4z(Y), (f32x4){0.f, 0.f, 0.f, 0.f}, 0, 0, 0)
                    f32x4 nt = (f32x4){0.f, 0.f, 0.f, 0.f};
#pragma unroll
                    for (int ks = 0; ks < 2; ++ks) nt = __builtin_amdgcn_mfma_f32_16x16x32_bf16(ld16(Rm + c * MP + 16 * g + 64 * ks), ld16(Lm + c * MP + 16 * g + 64 * ks), nt, 0, 0, 0);
                    f32x4 id;
#pragma unroll
                    for (int r = 0; r < 4; ++r) { nt[r] = (c < 4 * g + r) ? nt[r] : 0.f; id[r] = (4 * g + r == c) ? 1.f : 0.f; }
                    const f32x4 n2 = MM(nt, x), n2t = MM(x, nt);
                    const f32x4 n4 = MM(n2t, n2), n4t = MM(n2, n2t);
                    const f32x4 n8 = MM(n4t, n4);
                    const f32x4 t1t = MM(id + n2, id - nt);
                    const f32x4 t2t = MM(id + n4, t1t);
                    const f32x4 inv = MM(t2t, id + n8);
#undef MM
                    *(LAS v2u*)(SMn + 1536 + c * 32 + g * 8) = (v2u){pk2c(-inv.x, -inv.y), pk2c(-inv.z, -inv.w)};
#else
                    LAS float* Nf = (LAS float*)(L + O_NF);
#pragma unroll
                    for (int r = 0; r < 4; ++r) Nf[(4 * g + r) * 16 + c] = x[r];
                    LDS_WAIT();
                    float nrow[16][16];
#pragma unroll
                    for (int t = 0; t < 15; ++t) {
#pragma unroll
                        for (int q4 = 0; q4 < 4; ++q4) { const f32x4 nv = *(const LAS f32x4*)(Nf + t * 16 + 4 * q4); nrow[t][4 * q4] = nv.x; nrow[t][4 * q4 + 1] = nv.y; nrow[t][4 * q4 + 2] = nv.z; nrow[t][4 * q4 + 3] = nv.w; } }
                    float xr[16];
#pragma unroll
                    for (int t = 0; t < 16; ++t) xr[t] = (c == t) ? 1.f : 0.f;
#pragma unroll
                    for (int t = 0; t < 15; ++t) {
#pragma unroll
                        for (int t2 = t + 1; t2 < 16; ++t2) xr[t2] -= xr[t] * nrow[t][t2];
                    }
                    LAS bf16* InvT = (LAS bf16*)(SMn + 1536);
                    if (lane < 16) {
#pragma unroll
                        for (int t = 0; t < 16; ++t) InvT[t * 16 + c] = (bf16)pk2c(-xr[t], 0.f);
                    }
#endif
                } else {
                    LAS unsigned char* XT = SMn + (w - 1) * 512;
                    *(LAS v2u*)(XT + c * 32 + g * 8) = (v2u){pk2c(x.x, x.y), pk2c(x.z, x.w)};
                }
            }
            if (ci + 2 >= 0 && ci + 2 < NC) {
                const int cc = ci + 2;
                const LAS unsigned char* rwp = L + O_RAW + (cc & 3) * RAWB;
                LAS unsigned char* Mn = L + ((ci + 5) % 3) * PAR;
                switch (w) { case 0: scan_convert2<0>(rwp, Mn, dir, lane, K2); break; case 1: scan_convert2<1>(rwp, Mn, dir, lane, K2); break; case 2: scan_convert2<2>(rwp, Mn, dir, lane, K2); break; case 3: scan_convert2<3>(rwp, Mn, dir, lane, K2); break;
                             case 4: scan_convert2<4>(rwp, Mn, dir, lane, K2); break; case 5: scan_convert2<5>(rwp, Mn, dir, lane, K2); break; case 6: scan_convert2<6>(rwp, Mn, dir, lane, K2); break; default: scan_convert2<7>(rwp, Mn, dir, lane, K2); break; }
            }
            asm volatile("" :: "v"(yv), "v"(yp));
            if (doload) asm volatile("s_waitcnt vmcnt(2)" ::: "memory");
            else asm volatile("s_waitcnt vmcnt(0)" ::: "memory");
            __syncthreads();
        }
        if (tid < 256) { const LAS float* yb = (const LAS float*)(L + O_YB + ((NC - 1) & 1) * 4096); const int s = tid >> 4, i4 = (tid & 15) * 4; const int stp = (NC - 1) * CS + s; const int t = dir ? (SEQL - 1 - stp) : stp;
            const f32x4 yf = *(const LAS f32x4*)(yb + s * 64 + i4);
            *(GAS v2u*)((bf16*)F.Y + ((size_t)dir * T_TOK + (size_t)b * SEQL + t) * 1024 + h * 64 + i4) = (v2u){pk2c(yf.x, yf.y), pk2c(yf.z, yf.w)}; }
    }
}

__device__ __forceinline__ f32x4 shifted4(const bf16* P, size_t row, int t, int col, f32x4 mp, f32x4 mn) {
    const bf16* p = P + row * PC + col;
    const v2u z2 = *(const GAS v2u*)p; v2u zp2 = (v2u){0u, 0u}, zn2 = (v2u){0u, 0u};
    if (t > 0) zp2 = *(const GAS v2u*)(p - PC);
    if (t < SEQL - 1) zn2 = *(const GAS v2u*)(p + PC);
    const f32x4 z = (f32x4){bflo(z2.x), bfhi(z2.x), bflo(z2.y), bfhi(z2.y)}, zp = (f32x4){bflo(zp2.x), bfhi(zp2.x), bflo(zp2.y), bfhi(zp2.y)}, zn = (f32x4){bflo(zn2.x), bfhi(zn2.x), bflo(zn2.y), bfhi(zn2.y)};
    return z + mp * (zp - z) + mn * (zn - z);
}
struct CRow { v2u yf, yb, af, ab, g, r0, rp, rn, k0, kp, kn, v0, vp, vn; };
__device__ __forceinline__ void combine_load(CRow& R, const Frame& F, int rowi, int c0) {
    const size_t row = (size_t)rowi; const int t = rowi & (SEQL - 1); const bool hp = t > 0, hn = t < SEQL - 1;
    R.yf = __builtin_nontemporal_load((const GAS v2u*)((const bf16*)F.Y + row * 1024 + c0)); R.yb = __builtin_nontemporal_load((const GAS v2u*)((const bf16*)F.Y + ((size_t)T_TOK + row) * 1024 + c0));
    R.af = __builtin_nontemporal_load((const GAS v2u*)(F.AR + row * 1024 + c0)); R.ab = __builtin_nontemporal_load((const GAS v2u*)(F.AR + ((size_t)T_TOK + row) * 1024 + c0)); R.g = __builtin_nontemporal_load((const GAS v2u*)(F.G16 + row * 1024 + c0));
    const bf16* p = F.P + row * PC + c0; const v2u z = (v2u){0u, 0u};
    R.r0 = *(const GAS v2u*)(p + COL_R); R.rp = hp ? *(const GAS v2u*)(p + COL_R - PC) : z; R.rn = hn ? *(const GAS v2u*)(p + COL_R + PC) : z;
    R.k0 = *(const GAS v2u*)(p + COL_K); R.kp = hp ? *(const GAS v2u*)(p + COL_K - PC) : z; R.kn = hn ? *(const GAS v2u*)(p + COL_K + PC) : z;
    R.v0 = *(const GAS v2u*)(p + COL_V); R.vp = hp ? *(const GAS v2u*)(p + COL_V - PC) : z; R.vn = hn ? *(const GAS v2u*)(p + COL_V + PC) : z;
}
__device__ __forceinline__ f32x4 up4(v2u w) { return (f32x4){bflo(w.x), bfhi(w.x), bflo(w.y), bfhi(w.y)}; }
__device__ __forceinline__ v2u combine_row(const CRow& R, f32x4 mp_r, f32x4 mn_r, f32x4 mp_k, f32x4 mn_k, f32x4 mp_v, f32x4 mn_v, f32x4 kaw, f32x4 rkw, f32x4 lw, f32x4 lb) {
    const f32x4 y = up4(R.yf) + up4(R.yb);
    const f32x4 r0 = up4(R.r0), k0 = up4(R.k0), v0 = up4(R.v0);
    const f32x4 r = r0 + mp_r * (up4(R.rp) - r0) + mn_r * (up4(R.rn) - r0), k = k0 + mp_k * (up4(R.kp) - k0) + mn_k * (up4(R.kn) - k0), v = v0 + mp_v * (up4(R.vp) - v0) + mn_v * (up4(R.vn) - v0);
    const float mu = allred16((y.x + y.y) + (y.z + y.w)) * (1.f / 64.f);
    const f32x4 d = y - mu;
    const float var = allred16((d.x * d.x + d.y * d.y) + (d.z * d.z + d.w * d.w)) * (1.f / 64.f);
    const f32x4 yn = d * __builtin_amdgcn_rsqf(var + 64e-5f) * lw + lb;
    const f32x4 am = (up4(R.af) + up4(R.ab)) * 0.5f;
    const f32x4 km = k * ((am - 1.0f) * kaw + 1.0f);
    const f32x4 pr = r * km * rkw;
    const float bs = allred16((pr.x + pr.y) + (pr.z + pr.w));
    const f32x4 o = (yn + v * bs) * up4(R.g);
    return (v2u){pk2c(o.x, o.y), pk2c(o.z, o.w)};
}
__device__ __forceinline__ void p5_combine(Frame& F, int part, int nparts) {
    int lane_c = F.lane; asm volatile("" : "+v"(lane_c));
    const int gw = F.vcu * NWAVES + F.wave, NGW = F.G * NWAVES, lane = lane_c;
    bf16* MIX = F.H;
    const int q = gw & 3, c0 = q * 256 + lane * 4;
    const f32x4 mp_r = *(const f32x4*)(F.mu_prev + c0), mn_r = *(const f32x4*)(F.mu_next + c0), mp_k = *(const f32x4*)(F.mu_prev + 1024 + c0), mn_k = *(const f32x4*)(F.mu_next + 1024 + c0),
                mp_v = *(const f32x4*)(F.mu_prev + 2048 + c0), mn_v = *(const f32x4*)(F.mu_next + 2048 + c0), kaw = *(const f32x4*)(F.k_a + c0), rkw = *(const f32x4*)(F.r_k + c0),
                lw = *(const f32x4*)(F.lnx_w + c0), lb = *(const f32x4*)(F.lnx_b + c0);
    const int stride = NGW >> 2;
    const int nit = (T_TOK - (gw >> 2) + 4 * stride - 1) / (4 * stride), it0 = nit * part / nparts, it1 = nit * (part + 1) / nparts;
    for (int it = it0; it < it1; ++it) { const int rowi = (gw >> 2) + it * 4 * stride;
        CRow R[4]; int rw4[4]; bool ok4[4];
#pragma unroll
        for (int u = 0; u < 4; ++u) { rw4[u] = rowi + u * stride; ok4[u] = rw4[u] < T_TOK; combine_load(R[u], F, ok4[u] ? rw4[u] : rowi, c0); }
        v2u o4[4];
#pragma unroll
        for (int u = 0; u < 4; ++u) o4[u] = combine_row(R[u], mp_r, mn_r, mp_k, mn_k, mp_v, mn_v, kaw, rkw, lw, lb);
#pragma unroll
        for (int u = 0; u < 4; ++u) if (ok4[u]) *(GAS v2u*)(MIX + (size_t)rw4[u] * 2048 + c0) = o4[u];
    }
}

__device__ __forceinline__ unsigned max32(const unsigned (&k)[32]) {
    unsigned m[8];
#pragma unroll
    for (int i = 0; i < 8; ++i) m[i] = umax(umax(k[4 * i], k[4 * i + 1]), umax(k[4 * i + 2], k[4 * i + 3]));
    return umax(umax(umax(m[0], m[1]), umax(m[2], m[3])), umax(umax(m[4], m[5]), umax(m[6], m[7])));
}
__device__ __forceinline__ void p9_peer(Frame& F) {
    const int gw = F.vcu * NWAVES + F.wave, NGW = F.G * NWAVES, lane = F.lane;
    LAS unsigned* sel = (LAS unsigned*)(F.lds + F.wave * 4096);
    LAS unsigned* elist = sel + 256;
    LAS float* glist = (LAS float*)(sel + 384);
    LAS float* alist = (LAS float*)(sel + 512);
    const float* S = F.S;
    unsigned pab[7];
#pragma unroll
    for (int i = 0; i < 7; ++i) pab[i] = kStair[(lane & 7) * 7 + i];
    for (int tok = gw; tok < T_TOK; tok += NGW) {
      float o[32], h2f[32]; float inv_rstd2 = 0.f;
#pragma unroll
      for (int i = 0; i < 32; ++i) o[i] = 0.f;
      for (int rep = 0; rep < NREP(8); ++rep) {
        unsigned key[32], top[16];
        { const int g4 = lane >> 2, q4 = lane & 3;
          typedef _Float16 h8 __attribute__((ext_vector_type(8)));
          const GAS h8* sp = (const GAS h8*)((const _Float16*)S + (size_t)tok * 2048 + g4 * 128 + q4 * 32);
#pragma unroll
          for (int i = 0; i < 4; ++i) { const h8 v = __builtin_nontemporal_load(&sp[i]);
#pragma unroll
              for (int j = 0; j < 8; ++j) key[8 * i + j] = (f2sort((float)v[j]) & 0xFFFFFF80u) | (unsigned)(q4 * 32 + 8 * i + j); }
#pragma unroll
          for (int r = 0; r < 16; ++r) {
              unsigned m = max32(key);
              m = umax(m, dppu<0xB1>(m)); m = umax(m, dppu<0x4E>(m));
              top[r] = m;
#pragma unroll
              for (int i = 0; i < 32; ++i) key[i] = (key[i] == m) ? 0u : key[i];
          }
          if (q4 == 0) {
#pragma unroll
              for (int r = 0; r < 16; r += 4) *(LAS v4u*)(sel + g4 * 16 + r) = (v4u){top[r], top[r + 1], top[r + 2], top[r + 3]};
          }
        }
        LDS_WAIT();
        { const int hd = lane >> 3, q8 = lane & 7;
          const LAS unsigned* s1p = sel + (2 * hd) * 16; const LAS unsigned* s2p = sel + (2 * hd + 1) * 16;
          unsigned k7[7];
#pragma unroll
          for (int i = 0; i < 7; ++i) { const unsigned ab = pab[i]; const float sv = sort2f(s1p[(ab >> 4) & 15u] & 0xFFFFFF80u) + sort2f(s2p[ab & 15u] & 0xFFFFFF80u);
              k7[i] = (ab != 0xFFu) ? ((f2sort(sv) & 0xFFFFFF00u) | ab) : 0u; }
#pragma unroll
          for (int r = 0; r < 16; ++r) {
              unsigned m = umax(umax(umax(k7[0], k7[1]), umax(k7[2], k7[3])), umax(umax(k7[4], k7[5]), k7[6]));
              m = umax(m, dppu<0xB1>(m)); m = umax(m, dppu<0x4E>(m)); m = umax(m, dppu<0x141>(m));
              top[r] = m;
#pragma unroll
              for (int i = 0; i < 7; ++i) k7[i] = (k7[i] == m) ? 0u : k7[i];
          }
          const float v0 = sort2f(top[0] & 0xFFFFFF00u);
#pragma unroll
          for (int r = 0; r < 16; ++r) if (q8 == (r & 7)) { const unsigned ci = top[r] & 0xFFu; const unsigned e1 = s1p[ci >> 4] & 0x7Fu, e2 = s2p[ci & 15u] & 0x7Fu;
              elist[hd * 16 + r] = e1 * 128u + e2; glist[hd * 16 + r] = sort2f(top[r] & 0xFFFFFF00u) - v0; }
        }
        LDS_WAIT();
        { const GAS v2u* xr = (const GAS v2u*)((const bf16*)F.Y + (size_t)tok * DMODEL) + lane; v2u xw[8]; f32x4 xv[8]; float ss = 0.f;
#pragma unroll
          for (int m = 0; m < 8; ++m) xw[m] = __builtin_nontemporal_load(&xr[64 * m]);
#pragma unroll
          for (int m = 0; m < 8; ++m) xv[m] = (f32x4){bflo(xw[m].x), bfhi(xw[m].x), bflo(xw[m].y), bfhi(xw[m].y)};
#pragma unroll
          for (int i = 0; i < 8; ++i) ss += (xv[i].x * xv[i].x + xv[i].y * xv[i].y) + (xv[i].z * xv[i].z + xv[i].w * xv[i].w);
          inv_rstd2 = sqrtf(wave_sum(ss) * (1.f / DMODEL) + 1e-6f); const float rstd = 1.0f / inv_rstd2;
          const GAS f32x4* wr = (const GAS f32x4*)F.norm2_w + lane;
#pragma unroll
          for (int m = 0; m < 8; ++m) { const f32x4 wv = wr[64 * m]; const f32x4 a = xv[m];
              h2f[4 * m + 0] = a.x * rstd * wv.x; h2f[4 * m + 1] = a.y * rstd * wv.y; h2f[4 * m + 2] = a.z * rstd * wv.z; h2f[4 * m + 3] = a.w * rstd * wv.w; }
          const float g0 = __expf(glist[lane] * rstd), g1 = __expf(glist[64 + lane] * rstd);
          const float z0 = allred16(g0), z1 = allred16(g1);
          glist[lane] = g0 / z0; glist[64 + lane] = g1 / z1;
        }
        LDS_WAIT();
        for (int k0 = 0; k0 < 128; k0 += 8) {
            v4u ua[8]; v2u ub[8]; float usc[8];
#pragma unroll
            for (int j = 0; j < 8; ++j) { const unsigned e = (unsigned)__builtin_amdgcn_readfirstlane((int)elist[k0 + j]); const unsigned char* up = F.U8 + (size_t)e * 1536;
                ua[j] = *(const GAS v4u*)(up + lane * 16); ub[j] = *(const GAS v2u*)(up + 1024 + lane * 8); usc[j] = F.US[e]; }
            float dd[8];
#pragma unroll
            for (int j = 0; j < 8; ++j) { const f32x32 uf = __builtin_amdgcn_cvt_scalef32_pk32_f32_fp6((v6u){ua[j].x, ua[j].y, ua[j].z, ua[j].w, ub[j].x, ub[j].y}, usc[j]);
                float d0 = 0.f, d1 = 0.f, d2 = 0.f, d3 = 0.f;
#pragma unroll
                for (int m = 0; m < 8; ++m) { d0 += uf[4 * m] * h2f[4 * m]; d1 += uf[4 * m + 1] * h2f[4 * m + 1]; d2 += uf[4 * m + 2] * h2f[4 * m + 2]; d3 += uf[4 * m + 3] * h2f[4 * m + 3]; }
                dd[j] = (d0 + d1) + (d2 + d3); }
            float e4[4], f2[2];
#pragma unroll
            for (int j = 0; j < 4; ++j) { const auto rr = __builtin_amdgcn_permlane32_swap(__float_as_uint(dd[j]), __float_as_uint(dd[j + 4]), false, false); e4[j] = __uint_as_float(rr[0]) + __uint_as_float(rr[1]); }
#pragma unroll
            for (int j = 0; j < 2; ++j) { const auto rr = __builtin_amdgcn_permlane16_swap(__float_as_uint(e4[j]), __float_as_uint(e4[j + 2]), false, false); f2[j] = __uint_as_float(rr[0]) + __uint_as_float(rr[1]); }
            allred16x2(f2[0], f2[1]);
            { const int q = lane >> 4, i0 = k0 + 2 * (q & 1) + 4 * (q >> 1);
              const float a0 = gelu_f(f2[0]) * glist[i0], a1 = gelu_f(f2[1]) * glist[i0 + 1];
              if ((lane & 15) == 0) { alist[i0] = a0; alist[i0 + 1] = a1; } }
        }
        LDS_WAIT();
        for (int k0 = 0; k0 < 128; k0 += PEER_RIF) {
            v4u va[PEER_RIF]; v2u vb[PEER_RIF]; float ac[PEER_RIF], vsc[PEER_RIF];
#pragma unroll
            for (int j = 0; j < PEER_RIF; ++j) { const unsigned e = (unsigned)__builtin_amdgcn_readfirstlane((int)elist[k0 + j]); const unsigned char* vp = F.V8 + (size_t)e * 1536;
                va[j] = *(const GAS v4u*)(vp + lane * 16); vb[j] = *(const GAS v2u*)(vp + 1024 + lane * 8); ac[j] = alist[k0 + j]; vsc[j] = F.VS[e]; }
#pragma unroll
            for (int j = 0; j < PEER_RIF; ++j) { const f32x32 vf = __builtin_amdgcn_cvt_scalef32_pk32_f32_fp6((v6u){va[j].x, va[j].y, va[j].z, va[j].w, vb[j].x, vb[j].y}, vsc[j]); const float a = ac[j];
#pragma unroll
                for (int m = 0; m < 32; ++m) o[m] += a * vf[m]; }
        }
      }
      if (NREP(8) > 1) {
#pragma unroll
          for (int i = 0; i < 32; ++i) o[i] *= (1.0f / NREP(8));
      }
        { GAS f32x4* xr = (GAS f32x4*)(F.out + (size_t)tok * DMODEL) + lane; float ss = 0.f;
          { const GAS f32x4* w2r = (const GAS f32x4*)F.norm2_w + lane;
#pragma unroll
            for (int m = 0; m < 8; ++m) { const f32x4 w2 = w2r[64 * m];
                o[4 * m + 0] += h2f[4 * m + 0] * inv_rstd2 * __builtin_amdgcn_rcpf(w2.x); o[4 * m + 1] += h2f[4 * m + 1] * inv_rstd2 * __builtin_amdgcn_rcpf(w2.y);
                o[4 * m + 2] += h2f[4 * m + 2] * inv_rstd2 * __builtin_amdgcn_rcpf(w2.z); o[4 * m + 3] += h2f[4 * m + 3] * inv_rstd2 * __builtin_amdgcn_rcpf(w2.w); } }
#pragma unroll
          for (int i = 0; i < 32; ++i) ss += o[i] * o[i];
          const float rstd = 1.0f / sqrtf(wave_sum(ss) * (1.f / DMODEL) + 1e-6f);
          const GAS f32x4* wr = (const GAS f32x4*)F.normf_w + lane;
#pragma unroll
          for (int m = 0; m < 8; ++m) { const f32x4 wv = wr[64 * m];
              __builtin_nontemporal_store((f32x4){o[4 * m + 0] * rstd * wv.x, o[4 * m + 1] * rstd * wv.y, o[4 * m + 2] * rstd * wv.z, o[4 * m + 3] * rstd * wv.w}, &xr[64 * m]); }
        }
        LDS_WAIT();
    }
}

struct Args { const float* in[24]; float* out; unsigned char* ws; int ph_lo, ph_hi, li, pad; };
__global__ void __launch_bounds__(NWAVES * 64, 2) hybrid_fwd(Args args) {
    extern __shared__ __attribute__((aligned(16))) unsigned char lds[];
    Frame F;
    F.lds = (LAS unsigned char*)lds;
    F.MISC = (volatile LAS unsigned*)(F.lds + MISC_OFF);
    F.tid = threadIdx.x; F.lane = F.tid & 63; F.wave = __builtin_amdgcn_readfirstlane(F.tid >> 6);
    F.G = gridDim.x; { const int bx = blockIdx.x; F.vcu = (F.G % 8 == 0) ? (bx % 8) * (F.G / 8) + bx / 8 : bx; }
    unsigned char* ws = args.ws;
    F.ctl = (gu32*)(ws + WS_CTL);
    F.x = args.in[0]; F.w_in = args.in[1]; F.mu_prev = args.in[2]; F.mu_next = args.in[3]; F.w0 = args.in[4]; F.w2 = args.in[5]; F.a0 = args.in[6]; F.a2 = args.in[7]; F.g2 = args.in[8];
    F.k_k = args.in[9]; F.k_a = args.in[10]; F.r_k = args.in[11]; F.lnx_w = args.in[12]; F.lnx_b = args.in[13]; F.qnw = args.in[14]; F.knw = args.in[15]; F.w_out = args.in[16];
    F.norm1_w = args.in[17]; F.norm2_w = args.in[18]; F.w_pq = args.in[19]; F.sub_keys = args.in[20]; F.u_tab = args.in[21]; F.v_tab = args.in[22]; F.normf_w = args.in[23];
    F.out = args.out;
    F.ROPE = (float*)(ws + WS_ROPE);
    F.H1 = (bf16*)args.out; F.INVR = (float*)(ws + WS_ROPE + 512 * 1024);
    F.WinT = (bf16*)(ws + WS_WINT); F.WoutT = (bf16*)(ws + WS_WOUTT); F.WsT = (bf16*)(ws + WS_WST);
    F.w2T = (bf16*)(ws + WS_LORA); F.a2T = F.w2T + 2 * 1024 * 96; F.g2T = F.a2T + 2 * 1024 * 96;
    F.H = (bf16*)(ws + WS_H); F.P = (bf16*)(ws + WS_P); F.AR = (bf16*)(ws + WS_AR); F.G16 = (bf16*)(ws + WS_G); F.Y = (float*)(ws + WS_Y);
    F.U16 = (bf16*)(ws + WS_P); F.V16 = F.U16 + (size_t)16384 * 2048;
    F.U8 = ws + WS_TAB; F.V8 = F.U8 + (size_t)16384 * 2048; F.US = (float*)(F.V8 + (size_t)16384 * 2048); F.VS = F.US + 16384;
    F.S = (float*)(ws + WS_P);
    for (int u = F.tid; u < (LDS_BYTES - LDSCTL_OFF) / 4; u += NWAVES * 64) ((LAS unsigned*)(F.lds + LDSCTL_OFF))[u] = 0u;
    __syncthreads();
    const int lo = args.ph_lo, hi = args.ph_hi;
    const bool multi = (hi - lo) > 1;
    XcdBarrier bar; bar.bar = (unsigned*)(F.ctl + CW_BAR); bar.x = 0; bar.st = nullptr;
    if (multi) bar = xcd_barrier_post((unsigned*)(F.ctl + CW_BAR), F.MISC + 8);
#define IN(k) (lo <= (k) && (k) < hi)
#define SEAM(k) do { if (IN(k) && IN((k) + 1)) xcd_barrier(bar); } while (0)

    if (IN(0)) { for (int rep = 0; rep < NREP(0); ++rep) p0_prologue(F); SEAM(0); }
    if (IN(1)) {
        pg8::Gemm g{F.H1, F.WinT, T_TOK, PC, DMODEL}; pg8::StaticOrder S; S.init(T_TOK, PC, F.G, (int)blockIdx.x);
        pg8::EpiBf16<0> E{F.P, PC, nullptr, 0, 0, 1.f};
        for (int rep = 0; rep < NREP(1); ++rep) pg8::gemm_phase<pg8::EpiBf16<0>, pg8::StaticOrder, true, true>(F.lds, g, S, E);
        { const int nwg = (T_TOK / 256) * (PC / 256), rem = nwg % F.G; const int first = rem, nidle = rem ? F.G - rem : F.G;
          const int bx = (int)blockIdx.x;
          if (bx >= (rem ? first : 0)) {
              const int iw = (bx - (rem ? first : 0)) * NWAVES + F.wave, NIW = nidle * NWAVES;
              for (int r0 = 2 * iw; r0 < 32768; r0 += 2 * NIW) { f32x4 ta[8], tb[8]; tab_load(F, r0, F.lane, ta); tab_load(F, r0 + 1, F.lane, tb); tab_finish(F, r0, F.lane, ta); tab_finish(F, r0 + 1, F.lane, tb); }
          } }
        SEAM(1);
    }
    if (IN(2)) { for (int rep = 1; rep < NREP(2); ++rep) p2_prep<false>(F); p2_prep<true>(F); SEAM(2); }
    if (IN(3)) { for (int rep = 0; rep < NREP(3); ++rep) p3_scan(F); SEAM(3); }
    if (IN(4)) {
        const attn_body::AttnTensors AT{(const attn_body::bf16*)(F.P + COL_Q), (const attn_body::bf16*)(F.P + COL_KA), (const attn_body::bf16*)(F.P + COL_VA), (attn_body::bf16*)(F.H + 1024)};
        const attn_body::StaticOrder S((int)F.G, F.vcu);
        if (NREP(4) > 1 || NREP(9) > 1) {
            for (int rep = 0; rep < NREP(4); ++rep) attn_body::attn_phase<attn_body::StaticOrder>((char*)lds, AT, S);
            for (int rep = 0; rep < NREP(9); ++rep) p5_combine(F, 0, 1);
        } else {
            const bool cfirst = (F.vcu & 1) != 0;
#pragma unroll 1
            for (int j = 0; j < 8; ++j) {
                if (((j & 1) == 0) == cfirst) p5_combine(F, j >> 1, 4);
                else { attn_body::AttnUnit u; if (S.next(j >> 1, u)) attn_body::attn_unit<8>(u.b, u.h, u.qb, AT.Q, AT.K, AT.V, AT.O, (char*)lds); }
            }
        }
        SEAM(4);
    }
    if (IN(5)) {
        pg8::Gemm g{F.H, F.WoutT, T_TOK, DMODEL, DMODEL}; pg8::StaticOrder S; S.init(T_TOK, DMODEL, F.G, (int)blockIdx.x);
        pg8::EpiX2 E{DMODEL, (const pg8::bf16_t*)F.H1, F.INVR, F.norm1_w, (pg8::bf16_t*)F.Y};
        for (int rep = 0; rep < NREP(5); ++rep) pg8::gemm_phase<pg8::EpiX2, pg8::StaticOrder, true, true>(F.lds, g, S, E);
        SEAM(5);
    }
    if (IN(7)) {
        pg8::Gemm g{(const bf16*)F.Y, F.WsT, T_TOK, DMODEL, DMODEL}; pg8::StaticOrder S; S.init(T_TOK, DMODEL, F.G, (int)blockIdx.x);
        pg8::EpiF16P E{(_Float16*)F.S, DMODEL};
        for (int rep = 0; rep < NREP(7); ++rep) pg8::gemm_phase<pg8::EpiF16P, pg8::StaticOrder, true, true>(F.lds, g, S, E);
        SEAM(7);
    }
    if (IN(8)) { p9_peer(F); }
#undef IN
#undef SEAM
}

extern "C" void kernel_launch(void* const* d_in, const int* in_sizes, int n_in, void* d_out, int out_size, void* d_ws, size_t ws_size, hipStream_t stream) {
    static int grid = 0;
    if (grid == 0) {
        if (n_in != 24 || out_size != T_TOK * DMODEL || ws_size < WS_END) { fprintf(stderr, "kernel_launch: unexpected shapes (n_in %d, out %d, ws %zu); nothing launched\n", n_in, out_size, ws_size); grid = -1; return; }
        int dev = 0, cus = 0, per_cu = 0;
        if (hipGetDevice(&dev) != hipSuccess || hipDeviceGetAttribute(&cus, hipDeviceAttributeMultiprocessorCount, dev) != hipSuccess) { grid = -1; return; }
        if (hipFuncSetAttribute((const void*)hybrid_fwd, hipFuncAttributeMaxDynamicSharedMemorySize, LDS_BYTES) != hipSuccess) { fprintf(stderr, "kernel_launch: hipFuncSetAttribute failed\n"); grid = -1; return; }
        if (hipOccupancyMaxActiveBlocksPerMultiprocessor(&per_cu, (const void*)hybrid_fwd, NWAVES * 64, LDS_BYTES) != hipSuccess || per_cu < 1) fprintf(stderr, "kernel_launch: occupancy query reports %d\n", per_cu);
        (void)hipGetLastError();
        grid = cus;
    }
    if (grid < 0) return;
    (void)hipMemsetAsync((char*)d_ws + WS_CTL, 0, CTL_ZERO_BYTES, stream);
    Args a{};
    for (int i = 0; i < 24; ++i) a.in[i] = (const float*)d_in[i];
    a.out = (float*)d_out; a.ws = (unsigned char*)d_ws;
#if MK_ONE_LAUNCH
    a.ph_lo = 0; a.ph_hi = N_PHASES; a.li = 0;
    hipLaunchKernelGGL(hybrid_fwd, dim3(grid), dim3(NWAVES * 64), LDS_BYTES, stream, a);
#else
    for (int p = 0; p < N_PHASES; ++p) { a.ph_lo = p; a.ph_hi = p + 1; a.li = p; hipLaunchKernelGGL(hybrid_fwd, dim3(grid), dim3(NWAVES * 64), LDS_BYTES, stream, a); }
#endif
}
```

```cpp
#include <hip/hip_runtime.h>
#include <cstdio>
#include <cstdint>
namespace pg8 {
#define PG8_LAS __attribute__((address_space(3)))
typedef unsigned short bf16_t;
typedef short bf16x8 __attribute__((ext_vector_type(8)));
typedef float f32x4 __attribute__((ext_vector_type(4)));
typedef unsigned u32x4 __attribute__((ext_vector_type(4)));
constexpr int BM = 256, BK = 64, HALF = 128, HTB = HALF * BK * 2  , STAGE_BYTES = 8 * HTB, NXCD = 8, WGM = 8;

__host__ __device__ __forceinline__ int lds_byte(int r, int c) { const int st = (r >> 4) * 2 + (c >> 5), rr = r & 15, cc = c & 31, ob = rr * 64 + cc * 2; return st * 1024 + (ob ^ (((ob >> 9) & 1) << 5)); }
__host__ __device__ __forceinline__ void stage_rc(int b, int& R, int& C) { const int st = b / 1024, sb = b % 1024, swz = sb ^ (((sb >> 9) & 1) << 5); R = (st >> 1) * 16 + swz / 64; C = (st & 1) * 32 + (swz % 64) / 2; }
__host__ __device__ __forceinline__ int perm32(int rho) { const int n = rho >> 4, i = rho & 15; return 8 * (i >> 2) + 4 * n + (i & 3); }

struct Unit { int pm, pn; };
struct Gemm { const bf16_t* A; const bf16_t* Bt; int M, N, K; };

struct StaticOrder {
    int nM, nN, nwg, G, c;
    __host__ __device__ void init(int M, int N, int G_, int c_) { nM = M / BM; nN = N / BM; nwg = nM * nN; G = G_; c = c_; }
    __host__ __device__ bool next(int i, Unit& u) const {
        const long L = (long)i * G + c; if (L >= nwg) return false;
        int wgid = (int)L; { const int q = nwg / NXCD, r = nwg % NXCD, xcd = wgid % NXCD, off = wgid / NXCD; wgid = (xcd < r ? xcd * (q + 1) : r * (q + 1) + (xcd - r) * q) + off; }
        const int nig = WGM * nN, gid = wgid / nig, fm = gid * WGM, gsz = (nM - fm) < WGM ? (nM - fm) : WGM;
        u.pm = fm + ((wgid % nig) % gsz); u.pn = (wgid % nig) / gsz; return true;
    }
    __device__ __forceinline__ void a_ready(const Unit&) const {}
    __device__ __forceinline__ void done(const Unit&) const {}
};

__device__ __forceinline__ unsigned cvt_pk_bf16(float lo, float hi) { unsigned r; asm volatile("v_cvt_pk_bf16_f32 %0, %1, %2" : "=v"(r) : "v"(lo), "v"(hi)); return r; }
typedef float f32x2 __attribute__((ext_vector_type(2)));
__device__ __forceinline__ f32x2 gelu_pk(f32x2 v) {
    const f32x2 av = __builtin_elementwise_abs(v), d = av * 0.2316418882f + 1.0f;
    f32x2 t; t.x = __builtin_amdgcn_rcpf(d.x); t.y = __builtin_amdgcn_rcpf(d.y);
    f32x2 q = t * 0.5307027145f + (-0.7265760135f); q = q * t + 0.7107068705f; q = q * t + (-0.142248368f); q = q * t + 0.127414796f; q = q * t;
    const f32x2 s = (v * v) * (-0.72134752044f);
    f32x2 e; e.x = __builtin_amdgcn_exp2f(s.x); e.y = __builtin_amdgcn_exp2f(s.y);
    const f32x2 m = v * (q * e), r = v - m;
    f32x2 o; o.x = v.x < 0.f ? m.x : r.x; o.y = v.y < 0.f ? m.y : r.y; return o;
}

template <int ACT  > struct EpiBf16 {
    static constexpr bool PERM = true, AFTER_DRAIN = false; static_assert(ACT == 0 || ACT == 1, "EpiBf16: ACT is 0 (none) or 1 (gelu_pk)");
    bf16_t* O; int ldc; const float* bias; int split_cols; size_t split_stride; float scale0;
    __device__ __forceinline__ void operator()(const f32x4 (&acc)[2][2][4][2], const Unit& u, int wr, int wc, int fr, int fq) const {
        const int row0 = u.pm * BM + wr * 64 + fr; int colt = u.pn * BM; bf16_t* base = O;
        float sc = 1.f; if (split_cols) { const int t = colt / split_cols; base += (size_t)t * split_stride; colt -= t * split_cols; if (t == 0) sc = scale0; }
        const int col0 = colt + wc * 32 + 8 * fq, bcol0 = u.pn * BM + wc * 32 + 8 * fq;
        f32x4 bv[2][2];
#pragma unroll
        for (int bj = 0; bj < 2; ++bj)
#pragma unroll
            for (int n = 0; n < 2; ++n) bv[bj][n] = bias ? *(const f32x4*)(bias + bcol0 + bj * HALF + 4 * n) : (f32x4){0.f, 0.f, 0.f, 0.f};
#pragma unroll
        for (int ai = 0; ai < 2; ++ai)
#pragma unroll
            for (int m = 0; m < 4; ++m) { bf16_t* rowp = base + (size_t)(row0 + ai * HALF + m * 16) * ldc + col0;
#pragma unroll
                for (int bj = 0; bj < 2; ++bj) { f32x4 v0 = acc[ai][bj][m][0] + bv[bj][0], v1 = acc[ai][bj][m][1] + bv[bj][1];
                    if (ACT == 1) { f32x2 a = gelu_pk((f32x2){v0[0], v0[1]}), b = gelu_pk((f32x2){v0[2], v0[3]}), c = gelu_pk((f32x2){v1[0], v1[1]}), d = gelu_pk((f32x2){v1[2], v1[3]});
                        v0 = (f32x4){a.x, a.y, b.x, b.y}; v1 = (f32x4){c.x, c.y, d.x, d.y}; }
                    v0 = v0 * sc; v1 = v1 * sc; u32x4 w; w.x = cvt_pk_bf16(v0[0], v0[1]); w.y = cvt_pk_bf16(v0[2], v0[3]); w.z = cvt_pk_bf16(v1[0], v1[1]); w.w = cvt_pk_bf16(v1[2], v1[3]);
                    *(u32x4*)(rowp + bj * HALF) = w; } }
    }
};
struct EpiF32Res {
    static constexpr bool PERM = false, AFTER_DRAIN = false;
    float* C; int ldc; const float* res;
    __device__ __forceinline__ void operator()(const f32x4 (&acc)[2][2][4][2], const Unit& u, int wr, int wc, int fr, int fq) const {
        const int row0 = u.pm * BM + wr * 64 + fr, col0 = u.pn * BM + wc * 32 + 4 * fq;
#pragma unroll
        for (int ai = 0; ai < 2; ++ai)
#pragma unroll
            for (int m = 0; m < 4; ++m) { const size_t off = (size_t)(row0 + ai * HALF + m * 16) * ldc + col0;
#pragma unroll
                for (int bj = 0; bj < 2; ++bj)
#pragma unroll
                    for (int n = 0; n < 2; ++n) { f32x4 v = acc[ai][bj][m][n]; if (res) v = v + *(const f32x4*)(res + off + bj * HALF + n * 16); *(f32x4*)(C + off + bj * HALF + n * 16) = v; } }
    }
};
struct EpiX2 {
    static constexpr bool PERM = true, AFTER_DRAIN = false;
    int ldc; const bf16_t* h1; const float* invr; const float* w; bf16_t* Xb;
    __device__ __forceinline__ void operator()(const f32x4 (&acc)[2][2][4][2], const Unit& u, int wr, int wc, int fr, int fq) const {
        const int row0 = u.pm * BM + wr * 64 + fr, col0 = u.pn * BM + wc * 32 + 8 * fq;
        f32x4 rw[2][2];
#pragma unroll
        for (int bj = 0; bj < 2; ++bj)
#pragma unroll
            for (int n = 0; n < 2; ++n) { const f32x4 wv = *(const f32x4*)(w + col0 + bj * HALF + 4 * n);
                rw[bj][n] = (f32x4){__builtin_amdgcn_rcpf(wv[0]), __builtin_amdgcn_rcpf(wv[1]), __builtin_amdgcn_rcpf(wv[2]), __builtin_amdgcn_rcpf(wv[3])}; }
#pragma unroll
        for (int ai = 0; ai < 2; ++ai)
#pragma unroll
            for (int m = 0; m < 4; ++m) { const int row = row0 + ai * HALF + m * 16; const size_t off = (size_t)row * ldc + col0; const float ir = invr[row];
#pragma unroll
                for (int bj = 0; bj < 2; ++bj) { const size_t o = off + bj * HALF; const u32x4 hw = __builtin_nontemporal_load((const u32x4*)(h1 + o));
                    const f32x4 x0 = (f32x4){__uint_as_float(hw.x << 16), __uint_as_float(hw.x & 0xffff0000u), __uint_as_float(hw.y << 16), __uint_as_float(hw.y & 0xffff0000u)};
                    const f32x4 x1 = (f32x4){__uint_as_float(hw.z << 16), __uint_as_float(hw.z & 0xffff0000u), __uint_as_float(hw.w << 16), __uint_as_float(hw.w & 0xffff0000u)};
                    const f32x4 v0 = acc[ai][bj][m][0] + x0 * ir * rw[bj][0], v1 = acc[ai][bj][m][1] + x1 * ir * rw[bj][1];
                    u32x4 w4; w4.x = cvt_pk_bf16(v0[0], v0[1]); w4.y = cvt_pk_bf16(v0[2], v0[3]); w4.z = cvt_pk_bf16(v1[0], v1[1]); w4.w = cvt_pk_bf16(v1[2], v1[3]);
                    *(u32x4*)(Xb + o) = w4; } }
    }
};
struct EpiF32P {
    static constexpr bool PERM = true, AFTER_DRAIN = false;
    float* C; int ldc;
    __device__ __forceinline__ void operator()(const f32x4 (&acc)[2][2][4][2], const Unit& u, int wr, int wc, int fr, int fq) const {
        const int row0 = u.pm * BM + wr * 64 + fr, col0 = u.pn * BM + wc * 32 + 8 * fq;
#pragma unroll
        for (int ai = 0; ai < 2; ++ai)
#pragma unroll
            for (int m = 0; m < 4; ++m) { const size_t off = (size_t)(row0 + ai * HALF + m * 16) * ldc + col0;
#pragma unroll
                for (int bj = 0; bj < 2; ++bj) { *(f32x4*)(C + off + bj * HALF) = acc[ai][bj][m][0]; *(f32x4*)(C + off + bj * HALF + 4) = acc[ai][bj][m][1]; } }
    }
};
struct EpiF16P {
    static constexpr bool PERM = true, AFTER_DRAIN = false;
    _Float16* C; int ldc;
    __device__ __forceinline__ void operator()(const f32x4 (&acc)[2][2][4][2], const Unit& u, int wr, int wc, int fr, int fq) const {
        typedef _Float16 h8 __attribute__((ext_vector_type(8)));
        const int row0 = u.pm * BM + wr * 64 + fr, col0 = u.pn * BM + wc * 32 + 8 * fq;
#pragma unroll
        for (int ai = 0; ai < 2; ++ai)
#pragma unroll
            for (int m = 0; m < 4; ++m) { const size_t off = (size_t)(row0 + ai * HALF + m * 16) * ldc + col0;
#pragma unroll
                for (int bj = 0; bj < 2; ++bj) { f32x4 v0 = acc[ai][bj][m][0], v1 = acc[ai][bj][m][1];
#pragma unroll
                    for (int j = 0; j < 4; ++j) { v0[j] = __builtin_amdgcn_fmed3f(v0[j], -60000.f, 60000.f); v1[j] = __builtin_amdgcn_fmed3f(v1[j], -60000.f, 60000.f); }
                    *(h8*)(C + off + bj * HALF) = (h8){(_Float16)v0[0], (_Float16)v0[1], (_Float16)v0[2], (_Float16)v0[3], (_Float16)v1[0], (_Float16)v1[1], (_Float16)v1[2], (_Float16)v1[3]}; } }
    }
};
template <class Epi, class Sched, bool ALIGN_EPI = false, bool SP2 = false>
__device__ __forceinline__ void gemm_phase(PG8_LAS unsigned char* lds, const Gemm g, const Sched& S, const Epi& E) {
    const int tid = threadIdx.x, wid = __builtin_amdgcn_readfirstlane(tid >> 6), lane = tid & 63, wr = wid >> 2, wc = wid & 3, fr = lane & 15, fq = lane >> 4;
    const int K = g.K, nt = K / BK;
    unsigned voffA[2], voffB[2];
#pragma unroll
    for (int i = 0; i < 2; ++i) { int R, C; stage_rc(tid * 16 + i * 8192, R, C); const int Rb = Epi::PERM ? ((R & ~31) + perm32(R & 31)) : R;
        voffA[i] = (unsigned)(R * K + C) * 2u; voffB[i] = (unsigned)(Rb * K + C) * 2u; }
    const size_t kstep = (size_t)(BK * 2);
    const size_t hstep = (size_t)HALF * K * 2;
    const size_t tstep = 2 * hstep;
    const unsigned ldsw = (unsigned)wid * 1024u;
    const int aoff = lds_byte(wr * 64 + fr, fq * 8), boff = lds_byte(wc * 32 + fr, fq * 8);
#define PG8_SA(b, h) (((b) * 2 + (h)) * HTB)
#define PG8_SB(b, h) ((4 + (b) * 2 + (h)) * HTB)
#define PG8_STAGE(bufoff, gbase, voff) do { _Pragma("unroll") for (int _i = 0; _i < 2; ++_i) \
        __builtin_amdgcn_global_load_lds((const unsigned*)((const char*)(gbase) + (voff)[_i]), (PG8_LAS unsigned*)(lds + (bufoff) + ldsw + _i * 8192), 16, 0, 0); } while (0)
#define PG8_LDA(dst, b, h) do { _Pragma("unroll") for (int m = 0; m < 4; ++m) _Pragma("unroll") for (int k = 0; k < 2; ++k) dst[m][k] = *(const PG8_LAS bf16x8*)(lds + PG8_SA(b, h) + aoff + m * 2048 + k * 1024); } while (0)
#define PG8_LDB(dst, b, h) do { _Pragma("unroll") for (int n = 0; n < 2; ++n) _Pragma("unroll") for (int k = 0; k < 2; ++k) dst[n][k] = *(const PG8_LAS bf16x8*)(lds + PG8_SB(b, h) + boff + n * 2048 + k * 1024); } while (0)
#define PG8_MMA(ai, bj, At, Bt) do { __builtin_amdgcn_s_setprio(1); _Pragma("unroll") for (int m = 0; m < 4; ++m) _Pragma("unroll") for (int n = 0; n < 2; ++n) _Pragma("unroll") for (int k = 0; k < 2; ++k) \
        acc[ai][bj][m][n] = __builtin_amdgcn_mfma_f32_16x16x32_bf16(Bt[n][k], At[m][k], acc[ai][bj][m][n], 0, 0, 0); __builtin_amdgcn_s_setprio(0); } while (0)
#define PG8_WAIT_V(n) asm volatile("s_waitcnt vmcnt(" #n ")" ::: "memory")
#define PG8_WAIT_L(n) asm volatile("s_waitcnt lgkmcnt(" #n ")" ::: "memory")
#define PG8_BAR __builtin_amdgcn_s_barrier()
#define PG8_SCHED __builtin_amdgcn_sched_barrier(0)
    Unit cur, nxt; int ui = 0;
    if (!S.next(0, cur)) return;
    f32x4 acc[2][2][4][2];
#pragma unroll
    for (int a = 0; a < 2; ++a)
#pragma unroll
        for (int b = 0; b < 2; ++b)
#pragma unroll
            for (int m = 0; m < 4; ++m)
#pragma unroll
                for (int n = 0; n < 2; ++n) acc[a][b][m][n] = (f32x4){0.f, 0.f, 0.f, 0.f};
    bf16x8 At[4][2], B0[2][2], B1[2][2];
    const char* cA = (const char*)g.A + (size_t)cur.pm * tstep; const char* cB = (const char*)g.Bt + (size_t)cur.pn * tstep;
    S.a_ready(cur);
    if constexpr (SP2) {
        PG8_STAGE(PG8_SB(0, 0), cB, voffB); PG8_STAGE(PG8_SB(0, 1), cB + hstep, voffB); PG8_STAGE(PG8_SA(0, 0), cA, voffA); PG8_STAGE(PG8_SA(0, 1), cA + hstep, voffA);
        if (wr == 1) PG8_BAR;
        PG8_WAIT_V(2); PG8_BAR;
        PG8_STAGE(PG8_SB(1, 0), cB + kstep, voffB); PG8_STAGE(PG8_SA(1, 0), cA + kstep, voffA); PG8_STAGE(PG8_SB(1, 1), cB + hstep + kstep, voffB);
        PG8_WAIT_V(6); PG8_BAR;
    } else {
        PG8_STAGE(PG8_SB(0, 0), cB, voffB); PG8_STAGE(PG8_SA(0, 0), cA, voffA); PG8_STAGE(PG8_SB(0, 1), cB + hstep, voffB); PG8_STAGE(PG8_SA(0, 1), cA + hstep, voffA);
        if (wr == 1) PG8_BAR;
        PG8_WAIT_V(4); PG8_BAR;
        PG8_STAGE(PG8_SB(1, 0), cB + kstep, voffB); PG8_STAGE(PG8_SA(1, 0), cA + kstep, voffA); PG8_STAGE(PG8_SB(1, 1), cB + hstep + kstep, voffB);
        PG8_WAIT_V(6); PG8_BAR;
    }
    for (;;) {
        const bool has_next = S.next(ui + 1, nxt);
        const char* nA = has_next ? (const char*)g.A + (size_t)nxt.pm * tstep : cA; const char* nB = has_next ? (const char*)g.Bt + (size_t)nxt.pn * tstep : cB;
        for (int t = 0; t < nt; t += 2) {
            const bool last = (t == nt - 2);
            const char* a1 = cA + (size_t)(t + 1) * kstep;
            const char* a2 = last ? nA : cA + (size_t)(t + 2) * kstep; const char* b2 = last ? nB : cB + (size_t)(t + 2) * kstep;
            const char* a3 = a2 + kstep; const char* b3 = b2 + kstep;
            if (last && has_next) S.a_ready(nxt);
            if constexpr (SP2) {
            PG8_LDB(B0, 0, 0); PG8_LDB(B1, 0, 1); PG8_SCHED; PG8_LDA(At, 0, 0); PG8_STAGE(PG8_SA(1, 1), a1 + hstep, voffA);
            PG8_WAIT_V(8); PG8_WAIT_L(0); PG8_BAR; PG8_MMA(0, 0, At, B0); PG8_MMA(0, 1, At, B1); PG8_BAR; PG8_SCHED;
            PG8_LDA(At, 0, 1); PG8_STAGE(PG8_SB(0, 0), b2, voffB); PG8_STAGE(PG8_SB(0, 1), b2 + hstep, voffB); PG8_STAGE(PG8_SA(0, 0), a2, voffA);
            PG8_WAIT_V(8); PG8_WAIT_L(0); PG8_BAR; PG8_MMA(1, 0, At, B0); PG8_MMA(1, 1, At, B1); PG8_BAR; PG8_SCHED;
            PG8_LDB(B0, 1, 0); PG8_LDB(B1, 1, 1); PG8_SCHED; PG8_LDA(At, 1, 0); PG8_STAGE(PG8_SA(0, 1), a2 + hstep, voffA);
            PG8_WAIT_V(8); PG8_WAIT_L(0); PG8_BAR; PG8_MMA(0, 0, At, B0); PG8_MMA(0, 1, At, B1); PG8_BAR; PG8_SCHED;
            PG8_LDA(At, 1, 1); PG8_STAGE(PG8_SB(1, 0), b3, voffB); PG8_STAGE(PG8_SB(1, 1), b3 + hstep, voffB); PG8_STAGE(PG8_SA(1, 0), a3, voffA);
            PG8_WAIT_V(8); PG8_WAIT_L(0); PG8_BAR; PG8_MMA(1, 0, At, B0); PG8_MMA(1, 1, At, B1); PG8_BAR; PG8_SCHED;
            } else {
            PG8_LDB(B0, 0, 0); PG8_SCHED; PG8_LDA(At, 0, 0); PG8_STAGE(PG8_SA(1, 1), a1 + hstep, voffA);
            PG8_WAIT_L(8); PG8_BAR; PG8_WAIT_L(0); PG8_MMA(0, 0, At, B0); PG8_BAR; PG8_SCHED;
            PG8_LDB(B1, 0, 1); PG8_STAGE(PG8_SB(0, 0), b2, voffB);
            PG8_BAR; PG8_WAIT_L(0); PG8_MMA(0, 1, At, B1); PG8_BAR;
            PG8_LDA(At, 0, 1); PG8_STAGE(PG8_SA(0, 0), a2, voffA);
            PG8_BAR; PG8_WAIT_L(0); PG8_MMA(1, 0, At, B0); PG8_BAR; PG8_SCHED;
            PG8_STAGE(PG8_SB(0, 1), b2 + hstep, voffB);
            PG8_WAIT_V(6); PG8_BAR; PG8_MMA(1, 1, At, B1); PG8_BAR;
            PG8_LDB(B0, 1, 0); PG8_SCHED; PG8_LDA(At, 1, 0); PG8_STAGE(PG8_SA(0, 1), a2 + hstep, voffA);
            PG8_WAIT_L(8); PG8_BAR; PG8_WAIT_L(0); PG8_MMA(0, 0, At, B0); PG8_BAR; PG8_SCHED;
            PG8_LDB(B1, 1, 1); PG8_STAGE(PG8_SB(1, 0), b3, voffB);
            PG8_BAR; PG8_WAIT_L(0); PG8_MMA(0, 1, At, B1); PG8_BAR;
            PG8_LDA(At, 1, 1); PG8_STAGE(PG8_SA(1, 0), a3, voffA);
            PG8_BAR; PG8_WAIT_L(0); PG8_MMA(1, 0, At, B0); PG8_BAR; PG8_SCHED;
            PG8_STAGE(PG8_SB(1, 1), b3 + hstep, voffB);
            PG8_WAIT_V(6); PG8_BAR; PG8_MMA(1, 1, At, B1); PG8_BAR;
            }
        }
        if constexpr (ALIGN_EPI) { if (wr == 0) PG8_BAR; }
        if constexpr (!Epi::AFTER_DRAIN) { E(acc, cur, wr, wc, fr, fq); S.done(cur); }
        if (!has_next) break;
#pragma unroll
        for (int a = 0; a < 2; ++a)
#pragma unroll
            for (int b = 0; b < 2; ++b)
#pragma unroll
                for (int m = 0; m < 4; ++m)
#pragma unroll
                    for (int n = 0; n < 2; ++n) acc[a][b][m][n] = (f32x4){0.f, 0.f, 0.f, 0.f};
        cur = nxt; cA = nA; cB = nB; ++ui;
        if constexpr (ALIGN_EPI) { if (wr == 1) PG8_BAR; }
    }
    PG8_WAIT_V(0);
    if constexpr (!ALIGN_EPI) { if (wr == 0) PG8_BAR; }
    PG8_BAR;
    if constexpr (Epi::AFTER_DRAIN) { E.fused(acc, cur, wr, wc, fr, fq, lds, wid, lane); S.done(cur); }
#undef PG8_SA
#undef PG8_SB
#undef PG8_STAGE
#undef PG8_LDA
#undef PG8_LDB
#undef PG8_MMA
#undef PG8_WAIT_V
#undef PG8_WAIT_L
#undef PG8_BAR
#undef PG8_SCHED
}
}
#include <hip/hip_bf16.h>
#include <cmath>
namespace attn_body {
using bf16=__hip_bfloat16;
using bf16x8=__attribute__((ext_vector_type(8)))short;
using s16x4=__attribute__((ext_vector_type(4)))short;
using f32x16=__attribute__((ext_vector_type(16)))float;
using u32x4=__attribute__((ext_vector_type(4)))unsigned;
constexpr int BATCH=8,NHEAD=16,SEQ=2048,D=64,PQ=5376,PO=2048;
constexpr int NW=8,QBLK=32,QB=QBLK*NW,KVBLK=64,NQB=SEQ/QB;
constexpr int ATTN_UNIT_ROWS=QB;
__device__ __forceinline__ int crow(int r,int hi){return (r&3)+8*(r>>2)+4*hi;}
#define SBAR() __builtin_amdgcn_sched_barrier(0)
constexpr int NSLOT=3, SLOTB=8192;
constexpr int LDS_K=0, LDS_V=NSLOT*SLOTB, LDS_WS=2*NSLOT*SLOTB, LDS_OST=LDS_WS+NW*64*4, LDS_BYTES=LDS_OST+NW*4096;
constexpr float C2=0.125f*1.4426950408889634f;
__device__ __forceinline__ void glds16(const void*gsrc,unsigned lds_dst){unsigned keep;
  asm volatile("s_mov_b32 %0, m0\n\ts_mov_b32 m0, %2\n\ts_nop 0\n\tglobal_load_lds_dwordx4 %1, off\n\ts_mov_b32 m0, %0":"=&s"(keep):"v"(gsrc),"s"(lds_dst):"memory");}
__device__ __forceinline__ float max3f(float a,float b,float c){float r;asm("v_max3_f32 %0, %1, %2, %3":"=v"(r):"v"(a),"v"(b),"v"(c));return r;}
__device__ __forceinline__ float max2f(float a,float b){float r;asm("v_max_f32_e32 %0, %1, %2":"=v"(r):"v"(a),"v"(b));return r;}
__device__ __forceinline__ float fadd_s(float a,float b){float r;asm("v_add_f32_e32 %0, %1, %2":"=v"(r):"v"(a),"v"(b));return r;}
__device__ __forceinline__ float fsub_s(float a,float b){float r;asm("v_sub_f32_e32 %0, %1, %2":"=v"(r):"v"(a),"v"(b));return r;}
typedef float f32x2_t __attribute__((ext_vector_type(2))); typedef __bf16 bf16x2_t __attribute__((ext_vector_type(2)));
__device__ __forceinline__ unsigned cvtpk_s(float lo,float hi){f32x2_t v={lo,hi};bf16x2_t b=__builtin_convertvector(v,bf16x2_t);return __builtin_bit_cast(unsigned,b);}
#define WAIT_BAR(N) asm volatile("s_waitcnt vmcnt(" #N ") lgkmcnt(0)\n\ts_barrier":::"memory")

__device__ __forceinline__ void qkt(f32x16&p0,f32x16&p1,const char*Kslot,const bf16x8*qr,const f32x16&negm,int r32,int hi){
  const char*kb=Kslot+hi*1024+r32*16;
  #pragma unroll
  for(int d0=0;d0<4;++d0){
    const bf16x8 b0=*reinterpret_cast<const bf16x8*>(kb+d0*2048);
    const bf16x8 b1=*reinterpret_cast<const bf16x8*>(kb+d0*2048+512);
    if(d0==0){p0=__builtin_amdgcn_mfma_f32_32x32x16_bf16(b0,qr[0],negm,0,0,0);p1=__builtin_amdgcn_mfma_f32_32x32x16_bf16(b1,qr[0],negm,0,0,0);}
    else{p0=__builtin_amdgcn_mfma_f32_32x32x16_bf16(b0,qr[d0],p0,0,0,0);p1=__builtin_amdgcn_mfma_f32_32x32x16_bf16(b1,qr[d0],p1,0,0,0);}}
}
typedef __attribute__((address_space(3))) const char* lds_cptr;
typedef short v4i16_t __attribute__((ext_vector_type(4)));
__device__ __forceinline__ void kload8(bf16x8*kf,lds_cptr kp){
  kf[0]=*(const __attribute__((address_space(3))) bf16x8*)(kp);      kf[1]=*(const __attribute__((address_space(3))) bf16x8*)(kp+512);
  kf[2]=*(const __attribute__((address_space(3))) bf16x8*)(kp+2048); kf[3]=*(const __attribute__((address_space(3))) bf16x8*)(kp+2560);
  kf[4]=*(const __attribute__((address_space(3))) bf16x8*)(kp+4096); kf[5]=*(const __attribute__((address_space(3))) bf16x8*)(kp+4608);
  kf[6]=*(const __attribute__((address_space(3))) bf16x8*)(kp+6144); kf[7]=*(const __attribute__((address_space(3))) bf16x8*)(kp+6656);
}
__device__ __forceinline__ void kload2(bf16x8*kf,lds_cptr kp,int j){ kf[2*j]=*(const __attribute__((address_space(3))) bf16x8*)(kp+j*2048); kf[2*j+1]=*(const __attribute__((address_space(3))) bf16x8*)(kp+j*2048+512); }
__device__ __forceinline__ s16x4 vtr(lds_cptr p){ return __builtin_bit_cast(s16x4,__builtin_amdgcn_ds_read_tr16_b64_v4i16((__attribute__((address_space(3))) v4i16_t*)p)); }
__device__ __forceinline__ float rowmax(const f32x16&p0,const f32x16&p1){
  float a=max3f(p0[0],p0[1],p1[0]),b=max3f(p0[2],p0[3],p1[1]);a=max3f(a,p1[2],p1[3]);
  #pragma unroll
  for(int r=4;r<16;r+=4){a=max3f(a,p0[r],p0[r+1]);b=max3f(b,p0[r+2],p0[r+3]);a=max3f(a,p1[r],p1[r+1]);b=max3f(b,p1[r+2],p1[r+3]);}
  const float m=max2f(a,b);
  auto rr=__builtin_amdgcn_permlane32_swap(__float_as_uint(m),__float_as_uint(m),false,false);
  return max2f(__uint_as_float(rr[0]),__uint_as_float(rr[1]));
}
__device__ __forceinline__ void pv(f32x16*o,int vb,bf16x8 pa0,bf16x8 pa1,bf16x8 pa2,bf16x8 pa3){
  #pragma unroll
  for(int d0=0;d0<2;++d0){s16x4 lo[4],hi[4];
    #pragma unroll
    for(int ks=0;ks<4;++ks){
      asm volatile("ds_read_b64_tr_b16 %0,%1 offset:%c2":"=&v"(lo[ks]):"v"(vb),"i"(d0*4096+ks*1024):"memory");
      asm volatile("ds_read_b64_tr_b16 %0,%1 offset:%c2":"=&v"(hi[ks]):"v"(vb),"i"(d0*4096+ks*1024+512):"memory");}
    asm volatile("s_waitcnt lgkmcnt(0)":::"memory");SBAR();
    #define PK(k) (bf16x8){lo[k][0],lo[k][1],lo[k][2],lo[k][3],hi[k][0],hi[k][1],hi[k][2],hi[k][3]}
    o[d0]=__builtin_amdgcn_mfma_f32_32x32x16_bf16(pa0,PK(0),o[d0],0,0,0);
    o[d0]=__builtin_amdgcn_mfma_f32_32x32x16_bf16(pa1,PK(1),o[d0],0,0,0);
    o[d0]=__builtin_amdgcn_mfma_f32_32x32x16_bf16(pa2,PK(2),o[d0],0,0,0);
    o[d0]=__builtin_amdgcn_mfma_f32_32x32x16_bf16(pa3,PK(3),o[d0],0,0,0);
    #undef PK
  }
}

#ifndef ATTN_STORE16
#define ATTN_STORE16(p,v) (*(u32x4*)(p)=(v))
#endif
template<int THRL> __device__ __forceinline__ void attn_unit(int b,int h,int qb,const bf16*Q,const bf16*__restrict__ K,const bf16*__restrict__ V,bf16*O,char*shm){
  const int tid=threadIdx.x,lane=tid&63,r32=lane&31,hi=lane>>5; const int wid=__builtin_amdgcn_readfirstlane(tid>>6);
  const long rowbase=(long)b*SEQ; const int q0=qb*QB;
  const bf16*Qw=Q+(rowbase+q0+wid*QBLK)*PQ+h*D;
  const bf16*Kh=K+rowbase*PQ+(h>>2)*D,*Vh=V+rowbase*PQ+(h>>2)*D;
  const unsigned lds0=(unsigned)(uintptr_t)shm;
  float*wsf=(float*)(shm+LDS_WS)+wid*64;
  const bf16*ksrc=Kh+(long)lane*PQ+wid*8;
  const bf16*vsrc=Vh+(long)(16*(wid&3)+(lane>>2))*PQ+(wid>>2)*32+(lane&3)*8;
  const unsigned kdst=lds0+LDS_K+wid*1024, vdst=lds0+LDS_V+wid*1024;
  #define DMA_K(t,slot) glds16(ksrc+(long)(t)*KVBLK*PQ,(unsigned)__builtin_amdgcn_readfirstlane(kdst+(slot)))
  #define DMA_V(t,slot) glds16(vsrc+(long)(t)*KVBLK*PQ,(unsigned)__builtin_amdgcn_readfirstlane(vdst+(slot)))
  const int vb0=(int)(lds0+LDS_V)+((lane>>4)&1)*32+(lane&3)*8+(4*hi+((lane&15)>>2))*64;
  const char*Kbase=shm+LDS_K; bf16x8 kf[8];
  const lds_cptr shm3=(lds_cptr)shm; const lds_cptr kp0=shm3+LDS_K+hi*1024+r32*16; const lds_cptr vp0=shm3+LDS_V+((lane>>4)&1)*32+(lane&3)*8+(4*hi+((lane&15)>>2))*64;
  const int NT=SEQ/KVBLK;
  DMA_K(0,0);DMA_V(0,0);DMA_K(1,SLOTB);
  bf16x8 qr[4];
  #pragma unroll
  for(int d0=0;d0<4;++d0)qr[d0]=*reinterpret_cast<const bf16x8*>(&Qw[(long)r32*PQ+d0*16+hi*8]);
  float mhat=0.f,l_reg=0.f;f32x16 o[2];o[0]=f32x16{};o[1]=f32x16{};f32x16 negm=f32x16{};asm volatile("":"+v"(negm));
  #define CMASK(P0,P1,t) do{}while(0)
  bool resc=false;
  #define START(P0,P1) do{ const float rm=rowmax(P0,P1); resc=false; \
    { const float dl=rm; mhat=fadd_s(mhat,dl); \
      _Pragma("unroll") for(int r=0;r<16;++r){P0[r]=fsub_s(P0[r],dl);P1[r]=fsub_s(P1[r],dl);} \
      _Pragma("unroll") for(int r=0;r<16;++r)negm[r]=-mhat; asm volatile("":"+v"(negm)); } \
    _Pragma("unroll") for(int r=0;r<16;++r)P0[r]=__builtin_amdgcn_exp2f(P0[r]); }while(0)
  #define RESC() do{ if(resc){ asm volatile("s_waitcnt lgkmcnt(0)":::"memory"); \
      _Pragma("unroll") for(int d_=0;d_<2;++d_) _Pragma("unroll") for(int r=0;r<16;++r)o[d_][r]*=wsf[crow(r,hi)]; } }while(0)
  f32x16 pA0,pA1,pB0,pB1;
  int sl_prev=0,sl_cur=0,sl_next=SLOTB;
  #define ROT() do{sl_prev=sl_cur;sl_cur=sl_next;sl_next=(sl_next==(NSLOT-1)*SLOTB)?0:sl_next+SLOTB;}while(0)
  DMA_K(2,2*SLOTB);
  WAIT_BAR(3);
  qkt(pA0,pA1,Kbase,qr,negm,r32,hi);asm volatile("s_nop 15\n\ts_nop 7":"+v"(pA0),"+v"(pA1));CMASK(pA0,pA1,0);
  START(pA0,pA1);
  _Pragma("unroll") for(int r=0;r<16;++r)pA1[r]=__builtin_amdgcn_exp2f(pA1[r]);
  WAIT_BAR(0);
  DMA_K(3,0);DMA_V(1,SLOTB);
  ROT();
  kload8(kf,kp0+sl_cur);
  WAIT_BAR(2);
  s16x4 vlo[8],vhi[8]; u32x4 pw0,pw1,pw2,pw3;
  #define PKW(P,B) cvtpk_s(P[B],P[B+1])
  #define PAF(k) __builtin_bit_cast(bf16x8,pw##k)
  #define VFR(i) (bf16x8){vlo[i][0],vlo[i][1],vlo[i][2],vlo[i][3],vhi[i][0],vhi[i][1],vhi[i][2],vhi[i][3]}
  #define PIN(x) asm volatile("":"+v"(x))
  #define MX3(a,b,c) __builtin_fmaxf(__builtin_fmaxf((a),(b)),(c))
  #define GAPA(MF,A0,A1,A2,A3,W0,W1,PW) do{ MF; sacc+=A0; sacc+=A1; sacc+=A2; sacc+=A3; PIN(sacc); W0; W1; PIN(PW); SBAR(); }while(0)
  #define EX(v) __builtin_amdgcn_exp2f(v)
  #define GAPB(MF,X,B) do{ MF; X[B]=EX(X[B]); X[B+1]=EX(X[B+1]); X[B+2]=EX(X[B+2]); X[B+3]=EX(X[B+3]); PIN(X); SBAR(); }while(0)
  #define VRD(i) do{ vlo[i]=vtr(vp_+(((i)>>2)*4096+((i)&3)*1024)); vhi[i]=vtr(vp_+(((i)>>2)*4096+((i)&3)*1024+512)); }while(0)
  #define KRD(G,j) do{ if(G){ kload2(kf,kp0+sl_next,j); SBAR(); } }while(0)
  #define STEP(C0,C1,P0,P1,t,GK,GV,GL) do{ SBAR(); \
    const lds_cptr vp_=vp0+sl_prev; \
    VRD(0); SBAR(); float sacc=(P0[0]+P0[1]); \
    GAPA(C0=__builtin_amdgcn_mfma_f32_32x32x16_bf16(kf[0],qr[0],negm,0,0,0), P0[2],P0[3],P0[4],P0[5],     pw0[0]=PKW(P0,0), pw0[1]=PKW(P0,2), pw0); \
    VRD(4); SBAR(); GAPA(C1=__builtin_amdgcn_mfma_f32_32x32x16_bf16(kf[1],qr[0],negm,0,0,0), P0[6],P0[7],P0[8],P0[9],     pw0[2]=PKW(P0,4), pw0[3]=PKW(P0,6), pw0); \
    VRD(1); SBAR(); GAPA(C0=__builtin_amdgcn_mfma_f32_32x32x16_bf16(kf[2],qr[1],C0,0,0,0),   P0[10],P0[11],P0[12],P0[13], pw1[0]=PKW(P0,8), pw1[1]=PKW(P0,10), pw1); \
    VRD(5); SBAR(); GAPA(C1=__builtin_amdgcn_mfma_f32_32x32x16_bf16(kf[3],qr[1],C1,0,0,0),   P0[14],P0[15],P1[0],P1[1],   pw1[2]=PKW(P0,12),pw1[3]=PKW(P0,14), pw1); \
    VRD(2); SBAR(); GAPA(C0=__builtin_amdgcn_mfma_f32_32x32x16_bf16(kf[4],qr[2],C0,0,0,0),   P1[2],P1[3],P1[4],P1[5],     pw2[0]=PKW(P1,0), pw2[1]=PKW(P1,2), pw2); \
    VRD(6); SBAR(); GAPA(C1=__builtin_amdgcn_mfma_f32_32x32x16_bf16(kf[5],qr[2],C1,0,0,0),   P1[6],P1[7],P1[8],P1[9],     pw2[2]=PKW(P1,4), pw2[3]=PKW(P1,6), pw2); \
    VRD(3); SBAR(); GAPA(C0=__builtin_amdgcn_mfma_f32_32x32x16_bf16(kf[6],qr[3],C0,0,0,0),   P1[10],P1[11],P1[12],P1[13], pw3[0]=PKW(P1,8), pw3[1]=PKW(P1,10), pw3); \
    VRD(7); SBAR(); GAPA(C1=__builtin_amdgcn_mfma_f32_32x32x16_bf16(kf[7],qr[3],C1,0,0,0),   P1[14],P1[15],0.f,0.f,       pw3[2]=PKW(P1,12),pw3[3]=PKW(P1,14), pw3); \
    l_reg+=sacc; \
    if(GK){DMA_K((t)+3,sl_cur);} if(GV){DMA_V((t)+1,sl_next);} \
    CMASK(C0,C1,t); \
    { float a=MX3(C0[0],C0[1],C1[0]),b=MX3(C0[2],C0[3],C1[1]); a=MX3(a,C1[2],C1[3]); \
      _Pragma("unroll") for(int r=4;r<16;r+=4){a=MX3(a,C0[r],C0[r+1]);b=MX3(b,C0[r+2],C0[r+3]);a=MX3(a,C1[r],C1[r+1]);b=MX3(b,C1[r+2],C1[r+3]);} \
      float rm=__builtin_fmaxf(a,b); { auto rr=__builtin_amdgcn_permlane32_swap(__float_as_uint(rm),__float_as_uint(rm),false,false); rm=__builtin_fmaxf(__uint_as_float(rr[0]),__uint_as_float(rr[1])); } \
      resc=false; \
      if(__builtin_expect(__any(rm>(float)THRL),0)){ const float dl=__builtin_fmaxf(rm,0.f); mhat+=dl; \
        _Pragma("unroll") for(int r=0;r<16;++r){C0[r]-=dl;C1[r]-=dl;} \
        _Pragma("unroll") for(int r=0;r<16;++r)negm[r]=-mhat; asm volatile("":"+v"(negm)); \
        const float f=__builtin_amdgcn_exp2f(-dl); l_reg*=f; if(hi==0)wsf[r32]=f; resc=true; } } \
    SBAR(); \
    GAPB(o[0]=__builtin_amdgcn_mfma_f32_32x32x16_bf16(PAF(0),VFR(0),o[0],0,0,0), C0,0); \
    GAPB(o[1]=__builtin_amdgcn_mfma_f32_32x32x16_bf16(PAF(0),VFR(4),o[1],0,0,0), C0,4); \
    KRD(GL,0); GAPB(o[0]=__builtin_amdgcn_mfma_f32_32x32x16_bf16(PAF(1),VFR(1),o[0],0,0,0), C0,8); \
    KRD(GL,1); GAPB(o[1]=__builtin_amdgcn_mfma_f32_32x32x16_bf16(PAF(1),VFR(5),o[1],0,0,0), C0,12); \
    KRD(GL,2); GAPB(o[0]=__builtin_amdgcn_mfma_f32_32x32x16_bf16(PAF(2),VFR(2),o[0],0,0,0), C1,0); \
    KRD(GL,3); GAPB(o[1]=__builtin_amdgcn_mfma_f32_32x32x16_bf16(PAF(2),VFR(6),o[1],0,0,0), C1,4); \
    GAPB(o[0]=__builtin_amdgcn_mfma_f32_32x32x16_bf16(PAF(3),VFR(3),o[0],0,0,0), C1,8); \
    GAPB(o[1]=__builtin_amdgcn_mfma_f32_32x32x16_bf16(PAF(3),VFR(7),o[1],0,0,0), C1,12); \
    }while(0)
  int t=1;
  #undef CMASK
  #define CMASK(P0,P1,t) do{}while(0)
  for(;t+5<NT;t+=2){
    STEP(pB0,pB1,pA0,pA1,t,true,true,true);     WAIT_BAR(2); RESC(); ROT();
    STEP(pA0,pA1,pB0,pB1,t+1,true,true,true);   WAIT_BAR(2); RESC(); ROT();
  }
  #undef CMASK
  #define CMASK(P0,P1,t) do{}while(0)
  #define ENDW(tt) do{ if((tt)+3<NT){WAIT_BAR(2);} else if((tt)+2<NT){WAIT_BAR(1);} else {WAIT_BAR(0);} }while(0)
  for(;t+1<NT;t+=2){
    STEP(pB0,pB1,pA0,pA1,t,(t+3<NT),(t+1<NT),(t+1<NT));       ENDW(t);   RESC(); ROT();
    STEP(pA0,pA1,pB0,pB1,t+1,(t+4<NT),(t+2<NT),(t+2<NT));     ENDW(t+1); RESC(); ROT();
  }
  STEP(pB0,pB1,pA0,pA1,NT-1,false,false,false); RESC();
  { float sacc=pB0[0]+pB0[1]; _Pragma("unroll") for(int r=2;r<16;++r)sacc+=pB0[r]; _Pragma("unroll") for(int r=0;r<16;++r)sacc+=pB1[r]; l_reg+=sacc;
    pw0=(u32x4){PKW(pB0,0),PKW(pB0,2),PKW(pB0,4),PKW(pB0,6)};pw1=(u32x4){PKW(pB0,8),PKW(pB0,10),PKW(pB0,12),PKW(pB0,14)};pw2=(u32x4){PKW(pB1,0),PKW(pB1,2),PKW(pB1,4),PKW(pB1,6)};pw3=(u32x4){PKW(pB1,8),PKW(pB1,10),PKW(pB1,12),PKW(pB1,14)};
    SBAR(); pv(o,vb0+sl_cur,PAF(0),PAF(1),PAF(2),PAF(3)); }
  #undef PKW
  #undef PAF
  #undef VFR
  #undef PIN
  #undef MX3
  #undef GAPA
  #undef GAPB
  #undef EX
  #undef VRD
  #undef KRD
  #undef STEP
  #undef ENDW
  {auto rr=__builtin_amdgcn_permlane32_swap(__float_as_uint(l_reg),__float_as_uint(l_reg),false,false);l_reg=__uint_as_float(rr[0])+__uint_as_float(rr[1]);}
  if(hi==0)wsf[32+r32]=l_reg;asm volatile("s_waitcnt lgkmcnt(0)":::"memory");
  float rli[16];
  #pragma unroll
  for(int r=0;r<16;++r)rli[r]=__builtin_amdgcn_rcpf(wsf[32+crow(r,hi)]);
  bf16*Ow=O+(rowbase+q0+wid*QBLK)*PO+h*D;
  { bf16*stg=(bf16*)(shm+LDS_OST)+wid*2048;
    #pragma unroll
    for(int r=0;r<16;++r){const int orow=crow(r,hi);
      #pragma unroll
      for(int d0=0;d0<2;++d0)stg[orow*64+d0*32+r32]=__float2bfloat16(o[d0][r]*rli[r]);}
    asm volatile("s_waitcnt lgkmcnt(0)":::"memory");
    #pragma unroll
    for(int i=0;i<4;++i){const int row=i*8+(lane>>3),ch=lane&7; const u32x4 v=*(const u32x4*)(stg+row*64+ch*8); ATTN_STORE16(Ow+(long)row*PO+ch*8,v);} }
  asm volatile("s_waitcnt lgkmcnt(0)\n\ts_barrier":::"memory");
  #undef DMA_K
  #undef DMA_V
  #undef CMASK
  #undef START
  #undef RESC
  #undef ROT
}
constexpr int ATTN_LDS_BYTES=LDS_BYTES;
struct AttnTensors { const bf16* Q; const bf16* K; const bf16* V; bf16* O; };
struct AttnUnit { int b; int h; int qb; };
struct StaticOrder {
  int vcu, G;
  __device__ __forceinline__ explicit StaticOrder(int grid,int v):vcu(v),G(grid){}
  __device__ __forceinline__ bool next(int i,AttnUnit&u)const{ const int id=vcu+i*G; if(id>=1024)return false; const int w=id&255, r=id>>8; const int bk=w>>3; u.b=bk>>2; u.h=(bk&3)*4+r; u.qb=w&7; return true; }
  __device__ __forceinline__ void a_ready(const AttnUnit&)const{}
  __device__ __forceinline__ void done(const AttnUnit&)const{}
};
template<class Sched,int THRL=8> __device__ __forceinline__ void attn_phase(char*lds,const AttnTensors&T,const Sched&S){
  AttnUnit u;
  for(int i=0;S.next(i,u);++i){ S.a_ready(u); attn_unit<THRL>(u.b,u.h,u.qb,T.Q,T.K,T.V,T.O,lds); S.done(u); }
}
#undef SBAR
#undef WAIT_BAR
}
constexpr int NWAVES = 8;
constexpr int T_TOK = 16384, SEQL = 2048, DMODEL = 2048, PC = 5376;
constexpr int COL_R = 0, COL_K = 1024, COL_V = 2048, COL_LORA = 3072, COL_Q = 3712, COL_KA = 4736, COL_VA = 4992;
#ifndef MK_ONE_LAUNCH
#define MK_ONE_LAUNCH 1
#endif
constexpr int N_PHASES = 9;
#ifndef REP_P
#define REP_P -1
#define REP_N 1
#endif
#define NREP(k) (((k) == REP_P) ? REP_N : 1)
#ifndef PEER_RIF
#define PEER_RIF 8
#endif
#ifndef SCAN_INV_MFMA
#define SCAN_INV_MFMA 1
#endif
constexpr size_t MiB = 1u << 20;
constexpr size_t WS_CTL = 0, CTL_ZERO_BYTES = 64 * 1024;
constexpr size_t WS_ROPE = 1 * MiB;
constexpr size_t WS_WINT = 2 * MiB, WS_WOUTT = 23 * MiB, WS_WST = 31 * MiB, WS_LORA = 39 * MiB;
constexpr size_t WS_H = 41 * MiB;
constexpr size_t WS_P = 105 * MiB;
constexpr size_t WS_AR = 273 * MiB, WS_G = 337 * MiB, WS_Y = 369 * MiB, WS_TAB = 433 * MiB, WS_END = 498 * MiB;
constexpr int CW_BAR = 4096;
constexpr int RING_BYTES = 131072, LDSCTL_OFF = RING_BYTES, MISC_OFF = LDSCTL_OFF + 320, LDS_BYTES = 147456;

#define GAS __attribute__((address_space(1)))
#define LAS __attribute__((address_space(3)))
typedef unsigned short bf16;
typedef unsigned v4u __attribute__((ext_vector_type(4)));
typedef unsigned v2u __attribute__((ext_vector_type(2)));
typedef float f32x4 __attribute__((ext_vector_type(4)));
typedef float f32x2 __attribute__((ext_vector_type(2)));
typedef float f32x16 __attribute__((ext_vector_type(16)));
typedef float f32x32 __attribute__((ext_vector_type(32)));
typedef unsigned v6u __attribute__((ext_vector_type(6)));
typedef short bf16x8 __attribute__((ext_vector_type(8)));
typedef __bf16 bf16x2v __attribute__((ext_vector_type(2)));
typedef GAS unsigned gu32;
#define RLX_AGENT __ATOMIC_RELAXED, __HIP_MEMORY_SCOPE_AGENT
#define LDS_WAIT() asm volatile("s_waitcnt lgkmcnt(0)" ::: "memory")
__device__ __forceinline__ unsigned f2bf(float f) { unsigned u = __builtin_bit_cast(unsigned, f); return (u + 0x7fffu + ((u >> 16) & 1u)) >> 16; }
__device__ __forceinline__ unsigned pk2(float lo, float hi) { return f2bf(lo) | (f2bf(hi) << 16); }
__device__ __forceinline__ unsigned pk2c(float lo, float hi) { const f32x2 v = {lo, hi}; const bf16x2v b = __builtin_convertvector(v, bf16x2v); return __builtin_bit_cast(unsigned, b); }
__device__ __forceinline__ float bf2f(unsigned short u) { return __uint_as_float((unsigned)u << 16); }
__device__ __forceinline__ float bflo(unsigned w) { return __uint_as_float(w << 16); }
__device__ __forceinline__ float bfhi(unsigned w) { return __uint_as_float(w & 0xffff0000u); }
__device__ __forceinline__ float sigmoid_f(float x) { return __builtin_amdgcn_rcpf(1.0f + __expf(-x)); }
__device__ __forceinline__ float tanh_f(float x) { return 1.0f - 2.0f * __builtin_amdgcn_rcpf(__expf(2.0f * x) + 1.0f); }
__device__ __forceinline__ float dot2bf(unsigned a, unsigned b, float acc) { return __builtin_amdgcn_fdot2_f32_bf16(__builtin_bit_cast(bf16x2v, a), __builtin_bit_cast(bf16x2v, b), acc, false); }
template <int CTRL> __device__ __forceinline__ float dppf(float x) { return __builtin_bit_cast(float, __builtin_amdgcn_mov_dpp(__builtin_bit_cast(int, x), CTRL, 0xf, 0xf, true)); }
template <int CTRL> __device__ __forceinline__ unsigned dppu(unsigned x) { return (unsigned)__builtin_amdgcn_mov_dpp((int)x, CTRL, 0xf, 0xf, true); }
__device__ __forceinline__ float allred16(float x) { x += dppf<0xB1>(x); x += dppf<0x4E>(x); x += dppf<0x141>(x); x += dppf<0x128>(x); return x; }
__device__ __forceinline__ float wave_sum(float v) {
    v += dppf<0xB1>(v); v += dppf<0x4E>(v); v += dppf<0x141>(v); v += dppf<0x140>(v);
    { const auto r = __builtin_amdgcn_permlane16_swap(__float_as_uint(v), __float_as_uint(v), false, false); v = __uint_as_float(r[0]) + __uint_as_float(r[1]); }
    { const auto r = __builtin_amdgcn_permlane32_swap(__float_as_uint(v), __float_as_uint(v), false, false); v = __uint_as_float(r[0]) + __uint_as_float(r[1]); }
    return v;
}
__device__ __forceinline__ void allred16x2(float& a, float& b) {
    asm("s_nop 1\n\t"
        "v_add_f32_dpp %0, %0, %0 quad_perm:[1,0,3,2] row_mask:0xf bank_mask:0xf\n\t"
        "v_add_f32_dpp %1, %1, %1 quad_perm:[1,0,3,2] row_mask:0xf bank_mask:0xf\n\t"
        "s_nop 0\n\t"
        "v_add_f32_dpp %0, %0, %0 quad_perm:[2,3,0,1] row_mask:0xf bank_mask:0xf\n\t"
        "v_add_f32_dpp %1, %1, %1 quad_perm:[2,3,0,1] row_mask:0xf bank_mask:0xf\n\t"
        "s_nop 0\n\t"
        "v_add_f32_dpp %0, %0, %0 row_half_mirror row_mask:0xf bank_mask:0xf\n\t"
        "v_add_f32_dpp %1, %1, %1 row_half_mirror row_mask:0xf bank_mask:0xf\n\t"
        "s_nop 0\n\t"
        "v_add_f32_dpp %0, %0, %0 row_ror:8 row_mask:0xf bank_mask:0xf\n\t"
        "v_add_f32_dpp %1, %1, %1 row_ror:8 row_mask:0xf bank_mask:0xf\n\t"
        "s_nop 0"
        : "+v"(a), "+v"(b));
}
__device__ __forceinline__ float wave_max(float v) {
    v = fmaxf(v, dppf<0xB1>(v)); v = fmaxf(v, dppf<0x4E>(v)); v = fmaxf(v, dppf<0x141>(v)); v = fmaxf(v, dppf<0x140>(v));
    { const auto r = __builtin_amdgcn_permlane16_swap(__float_as_uint(v), __float_as_uint(v), false, false); v = fmaxf(__uint_as_float(r[0]), __uint_as_float(r[1])); }
    { const auto r = __builtin_amdgcn_permlane32_swap(__float_as_uint(v), __float_as_uint(v), false, false); v = fmaxf(__uint_as_float(r[0]), __uint_as_float(r[1])); }
    return v;
}
__device__ __forceinline__ unsigned umax(unsigned a, unsigned b) { return a > b ? a : b; }
__device__ __forceinline__ unsigned f2sort(float f) { const unsigned u = __float_as_uint(f); return u ^ ((unsigned)((int)u >> 31) | 0x80000000u); }
__device__ __forceinline__ float sort2f(unsigned k) { const unsigned u = (k & 0x80000000u) ? (k ^ 0x80000000u) : ~k; return __uint_as_float(u); }
__device__ __forceinline__ float gelu_f(float v) {
    const float av = fabsf(v), t = __builtin_amdgcn_rcpf(av * 0.2316418882f + 1.0f);
    float q = t * 0.5307027145f + (-0.7265760135f); q = q * t + 0.7107068705f; q = q * t + (-0.142248368f); q = q * t + 0.127414796f; q = q * t;
    const float e = __builtin_amdgcn_exp2f((v * v) * (-0.72134752044f));
    const float m = v * (q * e);
    return v < 0.f ? m : v - m;
}

__device__ const unsigned char kStair[56] = {0, 1, 2, 3, 4, 5, 6, 7, 8, 9, 10, 11, 12, 13, 14, 15, 16, 17, 18, 19, 20, 21, 22, 23, 32, 33, 34, 35, 36, 48, 49, 50, 51, 64, 65, 66, 80, 81, 96, 97, 112, 113, 128, 144, 160, 176, 192, 208, 224, 240, 255, 255, 255, 255, 255, 255};
__device__ const double kRopeInv[16] = {1.0, 0.5623413251903491, 0.31622776601683794, 0.1778279410038923, 0.1, 0.05623413251903491, 0.031622776601683794, 0.01778279410038923,
                                        0.01, 0.005623413251903491, 0.0031622776601683794, 0.001778279410038923, 0.001, 0.0005623413251903491, 0.00031622776601683794, 0.0001778279410038923};

#define XB_TMO      128
#define XB_XCNT(j)  (256  + 64 * (j))
#define XB_XSUB(j)  (1280 + 64 * (j))
#define XB_XGEN(j)  (2304 + 64 * (j))
#define XB_TOP      3328
#define XB_TOPGEN   3392
#define XCD_BAR_WORDS 3456
#define XB_SPIN_CAP (1u << 18)

__device__ __forceinline__ unsigned xb_ld(unsigned* p)              { return __hip_atomic_load(p, __ATOMIC_RELAXED, __HIP_MEMORY_SCOPE_AGENT); }
__device__ __forceinline__ unsigned xb_add(unsigned* p, unsigned v) { return __hip_atomic_fetch_add(p, v, __ATOMIC_RELAXED, __HIP_MEMORY_SCOPE_AGENT); }
__device__ __forceinline__ unsigned xb_xcc_id() { return (unsigned)__builtin_amdgcn_s_getreg((3 << 11) | 20) & 0xFu; }
#define XB_SPIN(cond, bar) do { unsigned _sp = 0; while (cond) { __builtin_amdgcn_s_sleep(1); \
    if ((++_sp & 255u) == 0u) { if (xb_ld(&(bar)[XB_TMO])) break; if (_sp > XB_SPIN_CAP) { atomicAdd(&(bar)[XB_TMO], 1u); break; } } } } while (0)

struct XcdBarrier {
    unsigned* bar; unsigned x;
    volatile LAS unsigned* st;
};

__device__ __forceinline__ XcdBarrier xcd_barrier_post(unsigned* bar, volatile LAS unsigned* st) {
    XcdBarrier b; b.bar = bar; b.x = xb_xcc_id(); b.st = st;
    if (threadIdx.x == 0) (void)xb_add(&bar[XB_XCNT(b.x)], 1u);
    return b;
}
__device__ __forceinline__ void xcd_barrier_complete(unsigned* bar, unsigned x, unsigned& nloc, unsigned& nx) {
    const unsigned G = gridDim.x * gridDim.y * gridDim.z;
    unsigned sum, cnt, mine, sp = 0u;
    for (;;) {
        sum = 0u; cnt = 0u; mine = 0u;
#pragma unroll
        for (unsigned j = 0; j < 16; ++j) { const unsigned c = xb_ld(&bar[XB_XCNT(j)]); sum += c; cnt += (c > 0u) ? 1u : 0u; mine = (j == x) ? c : mine; }
        if (sum == G) break;
        __builtin_amdgcn_s_sleep(1);
        if ((++sp & 255u) == 0u) { if (xb_ld(&bar[XB_TMO])) break; if (sp > XB_SPIN_CAP) { atomicAdd(&bar[XB_TMO], 1u); break; } }
    }
    nloc = mine > 0u ? mine : 1u; nx = cnt > 0u ? cnt : 1u;
}

__device__ __forceinline__ void xcd_barrier(const XcdBarrier& b) {
    asm volatile("s_waitcnt vmcnt(0)" ::: "memory");
    __syncthreads();
    if (threadIdx.x == 0) {
        unsigned* bar = b.bar;
        __builtin_amdgcn_s_waitcnt(0);
        unsigned nloc = b.st[0], nx = b.st[1];
        if (nloc == 0u) { xcd_barrier_complete(bar, b.x, nloc, nx); b.st[0] = nloc; b.st[1] = nx; }
        const unsigned old = xb_add(&bar[XB_XSUB(b.x)], 1u);
        const unsigned gen = old / nloc;
        if (old + 1u == (gen + 1u) * nloc) {
            __builtin_amdgcn_fence(__ATOMIC_RELEASE, "agent");
            asm volatile("s_waitcnt vmcnt(0)" ::: "memory");
            const unsigned og = xb_add(&bar[XB_TOP], 1u);
            const unsigned tg = og / nx;
            if (og + 1u == (tg + 1u) * nx) xb_add(&bar[XB_TOPGEN], 1u);
            else XB_SPIN(xb_ld(&bar[XB_TOPGEN]) == tg, bar);
            __builtin_amdgcn_fence(__ATOMIC_ACQUIRE, "agent");
            xb_add(&bar[XB_XGEN(b.x)], 1u);
            asm volatile("s_waitcnt vmcnt(0)" ::: "memory");
        } else {
            XB_SPIN(xb_ld(&bar[XB_XGEN(b.x)]) == gen, bar);
            __builtin_amdgcn_fence(__ATOMIC_ACQUIRE, "agent");
            asm volatile("s_waitcnt vmcnt(0)" ::: "memory");
        }
    }
    __syncthreads();
}

struct Frame {
    LAS unsigned char* lds;
    volatile LAS unsigned* MISC;
    gu32* ctl;
    int tid, lane, wave;
    int vcu, G;
    const float *x, *w_in, *mu_prev, *mu_next, *w0, *w2, *a0, *a2, *g2, *k_k, *k_a, *r_k, *lnx_w, *lnx_b, *qnw, *knw, *w_out, *norm1_w, *norm2_w, *w_pq, *sub_keys, *u_tab, *v_tab, *normf_w;
    float* out;
    bf16 *WinT, *WoutT, *WsT, *w2T, *a2T, *g2T, *H1; float* INVR;
    bf16 *H, *P, *AR, *G16, *U16, *V16;
    float *Y, *ROPE, *S;
    unsigned char *U8, *V8; float *US, *VS;
};

__device__ __forceinline__ void p0_transpose_item(const float* W, int K, int N, bf16* WT, LAS float* scr, int item, int lane) {
    const int nblk = N / 32, kb = item / nblk, nb = item % nblk, k0 = 64 * kb, n0 = 32 * nb;
    float tv[32];
#pragma unroll
    for (int i = 0; i < 32; ++i) tv[i] = __builtin_nontemporal_load(&W[(size_t)(k0 + 2 * i + (lane >> 5)) * N + n0 + (lane & 31)]);
#pragma unroll
    for (int i = 0; i < 32; ++i) scr[(2 * i + (lane >> 5)) * 33 + (lane & 31)] = tv[i];
    LDS_WAIT(); asm volatile("" ::: "memory");
    const int c = lane & 7;
#pragma unroll
    for (int j = 0; j < 4; ++j) { const int n = (lane >> 3) + 8 * j; const LAS float* s = scr + (8 * c) * 33 + n;
        v4u o; o.x = pk2c(s[0 * 33], s[1 * 33]); o.y = pk2c(s[2 * 33], s[3 * 33]); o.z = pk2c(s[4 * 33], s[5 * 33]); o.w = pk2c(s[6 * 33], s[7 * 33]);
        *(GAS v4u*)(WT + (size_t)(n0 + n) * K + k0 + 8 * c) = o; }
    LDS_WAIT(); asm volatile("" ::: "memory");
}
__device__ __forceinline__ void rms_row_to_bf16(int lane, const float* xrow, const float* w, bf16* orow) {
    const GAS f32x4* xr = (const GAS f32x4*)xrow + lane;
    f32x4 v[8]; float s = 0.f;
#pragma unroll
    for (int j = 0; j < 8; ++j) { v[j] = xr[64 * j]; s += (v[j].x * v[j].x + v[j].y * v[j].y) + (v[j].z * v[j].z + v[j].w * v[j].w); }
    const float rstd = 1.0f / sqrtf(wave_sum(s) * (1.f / DMODEL) + 1e-6f);
    const GAS f32x4* wr = (const GAS f32x4*)w + lane;
    GAS v2u* o8 = (GAS v2u*)orow + lane;
#pragma unroll
    for (int j = 0; j < 8; ++j) { const f32x4 wv = wr[64 * j]; v2u o; o.x = pk2c(v[j].x * rstd * wv.x, v[j].y * rstd * wv.y); o.y = pk2c(v[j].z * rstd * wv.z, v[j].w * rstd * wv.w); o8[64 * j] = o; }
}
__device__ __forceinline__ void sincos_d(double x, double& s, double& c) {
    const double TWO_PI = 6.283185307179586476925286766559;
    const double k = __builtin_rint(x / TWO_PI); const double r = x - k * TWO_PI, r2 = r * r;
    double ts = r, tc = 1.0; s = r; c = 1.0;
    for (int n = 1; n <= 14; ++n) { tc *= -r2 / (double)((2 * n - 1) * (2 * n)); ts *= -r2 / (double)((2 * n) * (2 * n + 1)); c += tc; s += ts; }
}
__device__ __forceinline__ void rms_2rows_to_bf16(int lane, const float* x0, const float* x1, const float* w, bf16* o0, bf16* o1, float* inv2) {
    const GAS f32x4* xr0 = (const GAS f32x4*)x0 + lane; const GAS f32x4* xr1 = (const GAS f32x4*)x1 + lane;
    f32x4 v0[8], v1[8]; float s0 = 0.f, s1 = 0.f;
#pragma unroll
    for (int j = 0; j < 8; ++j) { v0[j] = __builtin_nontemporal_load(&xr0[64 * j]); v1[j] = __builtin_nontemporal_load(&xr1[64 * j]); }
#pragma unroll
    for (int j = 0; j < 8; ++j) { s0 += (v0[j].x * v0[j].x + v0[j].y * v0[j].y) + (v0[j].z * v0[j].z + v0[j].w * v0[j].w); s1 += (v1[j].x * v1[j].x + v1[j].y * v1[j].y) + (v1[j].z * v1[j].z + v1[j].w * v1[j].w); }
    const float i0 = sqrtf(wave_sum(s0) * (1.f / DMODEL) + 1e-6f), i1 = sqrtf(wave_sum(s1) * (1.f / DMODEL) + 1e-6f); const float r0 = 1.0f / i0, r1 = 1.0f / i1;
    if (lane == 0) *(f32x2*)inv2 = (f32x2){i0, i1};
    const GAS f32x4* wr = (const GAS f32x4*)w + lane;
    GAS v2u* p0 = (GAS v2u*)o0 + lane; GAS v2u* p1 = (GAS v2u*)o1 + lane;
#pragma unroll
    for (int j = 0; j < 8; ++j) { const f32x4 wv = wr[64 * j];
        p0[64 * j] = (v2u){pk2c(v0[j].x * r0 * wv.x, v0[j].y * r0 * wv.y), pk2c(v0[j].z * r0 * wv.z, v0[j].w * r0 * wv.w)};
        p1[64 * j] = (v2u){pk2c(v1[j].x * r1 * wv.x, v1[j].y * r1 * wv.y), pk2c(v1[j].z * r1 * wv.z, v1[j].w * r1 * wv.w)}; }
}
__device__ __forceinline__ void p0_prologue(Frame& F) {
    if (F.wave < 4) {
        const int aw = F.vcu * 4 + F.wave, NAW = F.G * 4;
        for (int m = 2 * aw; m < T_TOK; m += 2 * NAW) rms_2rows_to_bf16(F.lane, F.x + (size_t)m * DMODEL, F.x + (size_t)(m + 1) * DMODEL, F.norm1_w, F.H1 + (size_t)m * DMODEL, F.H1 + (size_t)(m + 1) * DMODEL, F.INVR + m);
        return;
    }
    LAS float* scr = (LAS float*)(F.lds + F.wave * 16384);
    const int gw = F.vcu * 4 + (F.wave - 4), NGW = F.G * 4;
    const int gtid = gw * 64 + F.lane, NT = NGW * 64;
    constexpr int I_IN = (2048 / 64) * (5248 / 32), I_OUT = (2048 / 64) * (2048 / 32);
    for (int it = gw; it < I_IN + I_OUT; it += NGW) {
        if (it < I_IN) p0_transpose_item(F.w_in, 2048, 5248, F.WinT, scr, it, F.lane);
        else p0_transpose_item(F.w_out, 2048, 2048, F.WoutT, scr, it - I_IN, F.lane);
    }
    for (int i = gtid; i < 128 * 2048 / 8; i += NT) ((GAS v4u*)(F.WinT + (size_t)5248 * 2048))[i] = (v4u){0u, 0u, 0u, 0u};
    for (int i = gtid; i < 4 * 96 * 1024; i += NT) { const int c = i & 1023, ml = i >> 10, mat = ml / 96, l = ml - mat * 96;
        const float v = (mat < 2 ? F.w2 : F.a2)[(size_t)((mat & 1) * 96 + l) * 1024 + c];
        F.w2T[(size_t)(((mat * 32 + (c >> 5)) * 6 + (l >> 4)) * 512) + ((((l >> 3) & 1) * 32 + (c & 31)) * 8) + (l & 7)] = (bf16)f2bf(v); }
    for (int i = gtid; i < 256 * 1024; i += NT) { const int c = i & 1023, l = i >> 10;
        F.g2T[(size_t)((((c >> 5) * 16 + (l >> 4)) * 512)) + ((((l >> 3) & 1) * 32 + (c & 31)) * 8) + (l & 7)] = (bf16)f2bf(F.g2[i]); }
    for (int i = gtid; i < 1024; i += NT) { double s, c; sincos_d((double)(i >> 4) * kRopeInv[i & 15], s, c); F.ROPE[2 * i] = (float)c; F.ROPE[2 * i + 1] = (float)s; }
    for (int tile = gw; tile < 4096; tile += NGW) {
        const int hp = tile >> 8, nt = (tile >> 6) & 3, dt = tile & 63, c32 = F.lane & 31, hi = F.lane >> 5;
        const GAS f32x4* ka = (const GAS f32x4*)(F.sub_keys + (size_t)(hp * 128 + nt * 32 + c32) * 128 + hi * 8);
        const GAS f32x4* wb = (const GAS f32x4*)(F.w_pq + (size_t)(dt * 32 + c32) * 2048 + hp * 128 + hi * 8);
        f32x16 acc;
#pragma unroll
        for (int r = 0; r < 16; ++r) acc[r] = 0.f;
#pragma unroll 1
        for (int kh = 0; kh < 2; ++kh) {
            f32x4 av[8], bv[8];
#pragma unroll
            for (int ks = 0; ks < 4; ++ks) { av[2 * ks] = ka[16 * kh + 4 * ks]; av[2 * ks + 1] = ka[16 * kh + 4 * ks + 1]; bv[2 * ks] = wb[16 * kh + 4 * ks]; bv[2 * ks + 1] = wb[16 * kh + 4 * ks + 1]; }
#pragma unroll
            for (int ks = 0; ks < 4; ++ks) {
                const f32x4 a0 = av[2 * ks], a1 = av[2 * ks + 1], b0 = bv[2 * ks], b1 = bv[2 * ks + 1];
                const v4u ah = (v4u){pk2c(a0.x, a0.y), pk2c(a0.z, a0.w), pk2c(a1.x, a1.y), pk2c(a1.z, a1.w)}, bh = (v4u){pk2c(b0.x, b0.y), pk2c(b0.z, b0.w), pk2c(b1.x, b1.y), pk2c(b1.z, b1.w)};
                const v4u al = (v4u){pk2c(a0.x - bflo(ah.x), a0.y - bfhi(ah.x)), pk2c(a0.z - bflo(ah.y), a0.w - bfhi(ah.y)), pk2c(a1.x - bflo(ah.z), a1.y - bfhi(ah.z)), pk2c(a1.z - bflo(ah.w), a1.w - bfhi(ah.w))};
                const v4u bl = (v4u){pk2c(b0.x - bflo(bh.x), b0.y - bfhi(bh.x)), pk2c(b0.z - bflo(bh.y), b0.w - bfhi(bh.y)), pk2c(b1.x - bflo(bh.z), b1.y - bfhi(bh.z)), pk2c(b1.z - bflo(bh.w), b1.w - bfhi(bh.w))};
                acc = __builtin_amdgcn_mfma_f32_32x32x16_bf16(__builtin_bit_cast(bf16x8, ah), __builtin_bit_cast(bf16x8, bh), acc, 0, 0, 0);
                acc = __builtin_amdgcn_mfma_f32_32x32x16_bf16(__builtin_bit_cast(bf16x8, ah), __builtin_bit_cast(bf16x8, bl), acc, 0, 0, 0);
                acc = __builtin_amdgcn_mfma_f32_32x32x16_bf16(__builtin_bit_cast(bf16x8, al), __builtin_bit_cast(bf16x8, bh), acc, 0, 0, 0);
            }
        }
        bf16* op = F.WsT + (size_t)(hp * 128 + nt * 32 + 4 * hi) * 2048 + dt * 32 + c32;
        const float w2d = F.norm2_w[dt * 32 + c32];
#pragma unroll
        for (int r = 0; r < 16; ++r) op[(size_t)((r & 3) + 8 * (r >> 2)) * 2048] = (bf16)pk2c(acc[r] * w2d, 0.f);
    }
}

__device__ __forceinline__ float shifted(const bf16* P, size_t row, int t, int col, float mp, float mn) {
    const bf16* p = P + row * PC + col;
    const float z = bf2f(p[0]);
    const float zp = (t > 0) ? bf2f(*(p - PC)) : 0.f;
    const float zn = (t < SEQL - 1) ? bf2f(p[PC]) : 0.f;
    return z + mp * (zp - z) + mn * (zn - z);
}

template <bool QKPREP> __device__ __forceinline__ void p2_prep(Frame& F) {
    LAS bf16* At = (LAS bf16*)F.lds;
    LAS bf16* Raw = (LAS bf16*)(F.lds + 41472);
    const int lane = F.lane, wave = F.wave, c32 = lane & 31, hi = lane >> 5;
    bf16* EW = F.H;
    for (int u = blockIdx.x; u < T_TOK / 32; u += F.G) {
        const int row0 = u * 32;
        for (int i = 0; i < 6; ++i) { const int item = F.tid + 512 * i;
            if (item < 34 * 80) { const int rr = item / 80, seg = item - rr * 80; const int row = row0 - 1 + rr;
                const bool ok = !((rr == 0 && (row0 & (SEQL - 1)) == 0) || (rr == 33 && ((row0 + 32) & (SEQL - 1)) == 0));
                v4u v = (v4u){0u, 0u, 0u, 0u};
                if (ok) v = __builtin_nontemporal_load((const GAS v4u*)(F.P + (size_t)row * PC + COL_LORA + seg * 8));
                *(LAS v4u*)(Raw + rr * 640 + seg * 8) = v; } }
        __syncthreads();
        for (int i = 0; i < 5; ++i) { const int item = F.tid + 512 * i, tok = item / 80, seg = item - tok * 80;
            const v4u z4 = *(const LAS v4u*)(Raw + (tok + 1) * 640 + seg * 8), p4 = *(const LAS v4u*)(Raw + tok * 640 + seg * 8), n4 = *(const LAS v4u*)(Raw + (tok + 2) * 640 + seg * 8);
            const f32x4 mpa = *(const f32x4*)(F.mu_prev + COL_LORA + seg * 8), mpb = *(const f32x4*)(F.mu_prev + COL_LORA + seg * 8 + 4), mna = *(const f32x4*)(F.mu_next + COL_LORA + seg * 8), mnb = *(const f32x4*)(F.mu_next + COL_LORA + seg * 8 + 4);
            float a[8];
#pragma unroll
            for (int j = 0; j < 8; ++j) { const unsigned zw = z4[j >> 1], pw = p4[j >> 1], nw = n4[j >> 1];
                const float z = (j & 1) ? bfhi(zw) : bflo(zw), zp = (j & 1) ? bfhi(pw) : bflo(pw), zn = (j & 1) ? bfhi(nw) : bflo(nw);
                const float mp = j < 4 ? mpa[j & 3] : mpb[j & 3], mn = j < 4 ? mna[j & 3] : mnb[j & 3];
                const float zs = z + mp * (zp - z) + mn * (zn - z);
                a[j] = seg < 24 ? tanh_f(zs) : (seg < 48 ? zs : sigmoid_f(zs)); }
            *(LAS v4u*)(At + tok * 648 + seg * 8) = (v4u){pk2c(a[0], a[1]), pk2c(a[2], a[3]), pk2c(a[4], a[5]), pk2c(a[6], a[7])}; }
        __syncthreads();
        LAS unsigned char* Ot = F.lds + 41472 + wave * 8704;
#define P2_WLOAD96(wf, b_) do { const bf16* wp_ = F.w2T + (size_t)((((b_) >> 2) * 32 + wave * 4 + ((b_) & 3)) * 6) * 512 + lane * 8; \
            _Pragma("unroll") for (int ks = 0; ks < 6; ++ks) wf[ks] = *(const bf16x8*)(wp_ + ks * 512); } while (0)
#define P2_MMA96(wf, acc, b_) do { _Pragma("unroll") for (int r = 0; r < 16; ++r) acc[r] = 0.f; \
            const LAS bf16* ap = At + c32 * 648 + ((b_) >> 2) * 96 + hi * 8; \
            _Pragma("unroll") for (int ks = 0; ks < 6; ++ks) acc = __builtin_amdgcn_mfma_f32_32x32x16_bf16(wf[ks], *(const LAS bf16x8*)(ap + ks * 16), acc, 0, 0, 0); } while (0)
#define P2_BIAS96(bvv, b_) do { const int mat = (b_) >> 2, ch0 = wave * 128 + ((b_) & 3) * 32 + 4 * hi; const float* bp = (mat < 2 ? F.w0 + mat * 1024 : F.a0 + (mat - 2) * 1024) + ch0; \
            _Pragma("unroll") for (int r4 = 0; r4 < 4; ++r4) bvv[r4] = *(const f32x4*)(bp + 8 * r4); } while (0)
#define P2_EPI96(acc, bvv, b_) do { const int mat = (b_) >> 2; const float sc = mat < 2 ? 0.6065306597126334f : 1.0f; \
            LAS unsigned char* tp = Ot + c32 * 272 + ((b_) & 3) * 64 + 8 * hi; \
            _Pragma("unroll") for (int r4 = 0; r4 < 4; ++r4) { const f32x4 bv = bvv[r4]; \
                const float o0 = sc * sigmoid_f(acc[4 * r4] + bv.x), o1 = sc * sigmoid_f(acc[4 * r4 + 1] + bv.y), o2 = sc * sigmoid_f(acc[4 * r4 + 2] + bv.z), o3 = sc * sigmoid_f(acc[4 * r4 + 3] + bv.w); \
                *(LAS v2u*)(tp + 16 * r4) = (v2u){pk2c(o0, o1), pk2c(o2, o3)}; } \
            if (((b_) & 3) == 3) { LDS_WAIT(); bf16* dp = (mat < 2 ? EW + (size_t)mat * T_TOK * 1024 : F.AR + (size_t)(mat - 2) * T_TOK * 1024) + (size_t)row0 * 1024 + wave * 128 + (lane & 15) * 8; \
                _Pragma("unroll") for (int i8 = 0; i8 < 8; ++i8) { const int rw_ = (lane >> 4) + 4 * i8; *(GAS v4u*)(dp + (size_t)rw_ * 1024) = *(const LAS v4u*)(Ot + rw_ * 272 + (lane & 15) * 16); } \
                LDS_WAIT(); } } while (0)
        { bf16x8 wa[6]; f32x16 acc; f32x4 bvv[4];
          P2_WLOAD96(wa, 0);
#pragma unroll 1
          for (int b = 0; b < 16; ++b) { P2_BIAS96(bvv, b); asm volatile("" ::: "memory"); P2_MMA96(wa, acc, b); asm volatile("" : "+v"(acc)); if (b + 1 < 16) P2_WLOAD96(wa, b + 1); asm volatile("" ::: "memory"); P2_EPI96(acc, bvv, b); } }
#undef P2_BIAS96
#undef P2_WLOAD96
#undef P2_MMA96
#undef P2_EPI96
#define P2_WLOADG(wf, cb_) do { const bf16* wp_ = F.g2T + (size_t)((wave * 4 + (cb_)) * 16) * 512 + lane * 8; \
            _Pragma("unroll") for (int ks = 0; ks < 16; ++ks) wf[ks] = *(const bf16x8*)(wp_ + ks * 512); } while (0)
        { bf16x8 ga[16]; f32x16 acc;
          P2_WLOADG(ga, 0);
#pragma unroll 1
          for (int cb = 0; cb < 4; ++cb) {
#pragma unroll
              for (int r = 0; r < 16; ++r) acc[r] = 0.f;
              const LAS bf16* ap = At + c32 * 648 + 384 + hi * 8;
#pragma unroll
              for (int ks = 0; ks < 16; ++ks) acc = __builtin_amdgcn_mfma_f32_32x32x16_bf16(ga[ks], *(const LAS bf16x8*)(ap + ks * 16), acc, 0, 0, 0);
              asm volatile("" : "+v"(acc));
              if (cb + 1 < 4) P2_WLOADG(ga, cb + 1);
              { LAS unsigned char* tp = Ot + c32 * 272 + cb * 64 + 8 * hi;
#pragma unroll
                for (int r4 = 0; r4 < 4; ++r4) *(LAS v2u*)(tp + 16 * r4) = (v2u){pk2c(acc[4 * r4], acc[4 * r4 + 1]), pk2c(acc[4 * r4 + 2], acc[4 * r4 + 3])}; }
              if (cb == 3) { LDS_WAIT(); bf16* dp = F.G16 + (size_t)row0 * 1024 + wave * 128 + (lane & 15) * 8;
#pragma unroll
                for (int i8 = 0; i8 < 8; ++i8) { const int rw_ = (lane >> 4) + 4 * i8; *(GAS v4u*)(dp + (size_t)rw_ * 1024) = *(const LAS v4u*)(Ot + rw_ * 272 + (lane & 15) * 16); }
                LDS_WAIT(); } } }
#undef P2_WLOADG
        if (QKPREP) for (int ib = 0; ib < 4; ++ib) {
            const int li = lane & 15;
            bf16* pp[5]; v2u xw[5]; f32x4 cs0[5], cs1[5]; int hq[5];
#pragma unroll
            for (int u5 = 0; u5 < 5; ++u5) { const int it4 = wave + NWAVES * (5 * ib + u5);
                const int item = it4 * 4 + (lane >> 4), tok = item / 20, hh = item - tok * 20;
                const size_t row = (size_t)(row0 + tok); const int t = (int)(row & (SEQL - 1));
                pp[u5] = F.P + row * PC + (hh < 16 ? COL_Q + hh * 64 : COL_KA + (hh - 16) * 64) + 4 * li; hq[u5] = hh;
                xw[u5] = *(const GAS v2u*)pp[u5];
                const int pos = (li < 8) ? (t >> 6) : (t & 63);
                cs0[u5] = *(const f32x4*)(F.ROPE + 2 * (pos * 16 + 4 * (li & 3))); cs1[u5] = *(const f32x4*)(F.ROPE + 2 * (pos * 16 + 4 * (li & 3)) + 4); }
            const f32x4 wq = *(const f32x4*)(F.qnw + 4 * li), wk = *(const f32x4*)(F.knw + 4 * li);
            v2u ow[5];
#pragma unroll
            for (int u5 = 0; u5 < 5; ++u5) {
                const f32x4 xv = (f32x4){bflo(xw[u5].x), bfhi(xw[u5].x), bflo(xw[u5].y), bfhi(xw[u5].y)};
                const float ss = allred16((xv.x * xv.x + xv.y * xv.y) + (xv.z * xv.z + xv.w * xv.w));
                const float rstd = __builtin_amdgcn_rsqf(ss * (1.f / 64.f) + 1e-6f);
                const f32x4 xn = xv * rstd * (hq[u5] < 16 ? wq : wk);
                f32x4 pr;
#pragma unroll
                for (int j = 0; j < 4; ++j) { const float up = dppf<0x104>(xn[j]), dn = dppf<0x114>(xn[j]); pr[j] = (li & 4) ? dn : up; }
                const f32x4 cc = (f32x4){cs0[u5].x, cs0[u5].z, cs1[u5].x, cs1[u5].z}, sn = (f32x4){cs0[u5].y, cs0[u5].w, cs1[u5].y, cs1[u5].w};
                f32x4 o = (li & 4) ? (xn * cc + pr * sn) : (xn * cc - pr * sn);
                if (hq[u5] < 16) o = o * attn_body::C2;
                ow[u5] = (v2u){pk2c(o.x, o.y), pk2c(o.z, o.w)}; }
#pragma unroll
            for (int u5 = 0; u5 < 5; ++u5) *(GAS v2u*)pp[u5] = ow[u5];
        }
        __syncthreads();
    }
}

__device__ __forceinline__ bf16x8 pack4z(f32x4 v) { const unsigned a = pk2c(v.x, v.y), b = pk2c(v.z, v.w); const v4u w = (v4u){a, b, 0u, 0u}; return __builtin_bit_cast(bf16x8, w); }
__device__ __forceinline__ bf16x8 ld8z(const LAS unsigned char* p) { const v2u a = *(const LAS v2u*)p; const v4u w = (v4u){a.x, a.y, 0u, 0u}; return __builtin_bit_cast(bf16x8, w); }
__device__ __forceinline__ bf16x8 ld16(const LAS unsigned char* p) { return *(const LAS bf16x8*)p; }
typedef short s16x4_t __attribute__((ext_vector_type(4)));
__device__ __forceinline__ void glds16s_nt(const void* gsrc, unsigned lds_dst) { unsigned keep;
    asm volatile("s_mov_b32 %0, m0\n\ts_mov_b32 m0, %2\n\ts_nop 0\n\tglobal_load_lds_dwordx4 %1, off nt\n\ts_mov_b32 m0, %0" : "=&s"(keep) : "v"(gsrc), "s"(lds_dst) : "memory"); }
__device__ __forceinline__ void glds16s(const void* gsrc, unsigned lds_dst) { unsigned keep;
    asm volatile("s_mov_b32 %0, m0\n\ts_mov_b32 m0, %2\n\ts_nop 0\n\tglobal_load_lds_dwordx4 %1, off\n\ts_mov_b32 m0, %0" : "=&s"(keep) : "v"(gsrc), "s"(lds_dst) : "memory"); }
__device__ __forceinline__ v2u vtr2(const LAS unsigned char* p) { return __builtin_bit_cast(v2u, __builtin_amdgcn_ds_read_tr16_b64_v4i16((LAS s16x4_t*)p)); }
__device__ __forceinline__ void tab_load(const Frame& F, int r, int lane, f32x4 (&v)[8]) {
    const int tb = r >> 14, row = r & 16383;
    const GAS f32x4* src = (const GAS f32x4*)((tb ? F.v_tab : F.u_tab) + (size_t)row * 2048) + lane;
#pragma unroll
    for (int j = 0; j < 8; ++j) v[j] = __builtin_nontemporal_load(&src[64 * j]);
}
__device__ __forceinline__ void tab_finish(const Frame& F, int r, int lane, const f32x4 (&v)[8]) {
    const int tb = r >> 14, row = r & 16383;
    float am = 0.f;
#pragma unroll
    for (int j = 0; j < 8; ++j) am = fmaxf(fmaxf(am, fmaxf(fabsf(v[j].x), fabsf(v[j].y))), fmaxf(fabsf(v[j].z), fabsf(v[j].w)));
    am = wave_max(am);
    const unsigned ab = __float_as_uint(am * (1.0f / 7.5f));
    const float sc = am > 0.f ? __uint_as_float((ab + 0x7FFFFFu) & 0x7F800000u) : 1.0f;
    f32x16 x, y;
#pragma unroll
    for (int j = 0; j < 8; ++j) { x[2 * j] = v[j].x; y[2 * j] = v[j].y; x[2 * j + 1] = v[j].z; y[2 * j + 1] = v[j].w; }
    const v6u p = __builtin_amdgcn_cvt_scalef32_2xpk16_fp6_f32(x, y, sc);
    unsigned char* drow = (tb ? F.V8 : F.U8) + (size_t)row * 1536;
    __builtin_nontemporal_store((v4u){p[0], p[1], p[2], p[3]}, (GAS v4u*)(drow + lane * 16)); __builtin_nontemporal_store((v2u){p[4], p[5]}, (GAS v2u*)(drow + 1024 + lane * 8));
    if (lane == 0) (tb ? F.VS : F.US)[row] = sc;
}
struct Conv2C { f32x2 mp_r, mn_r, mp_k, mn_k, mp_v, mn_v, kkw, kaw; };
template <int PAIRIDX> __device__ __forceinline__ void scan_convert2(const LAS unsigned char* rawp, LAS unsigned char* Mn, int dir, int lane, const Conv2C& K) {
    constexpr int CS = 16, S0 = 2 * PAIRIDX;
    const int half = lane >> 5, cp = lane & 31, s = S0 + half;
    const LAS unsigned* rw = (const LAS unsigned*)rawp + cp;
    unsigned pe[S0 > 0 ? S0 : 1];
#pragma unroll
    for (int sp = 0; sp < S0; ++sp) { const int rr0 = dir ? (CS - sp) : (sp + 1); pe[sp] = rw[(54 + rr0 - 1) * 32]; }
    const int rr = dir ? (CS - s) : (s + 1);
    const int rrE = dir ? (CS - S0) : (S0 + 1);
    const unsigned r0w = rw[rr * 32], rpw = rw[(rr - 1) * 32], rnw = rw[(rr + 1) * 32];
    const unsigned k0w = rw[(18 + rr) * 32], kpw = rw[(18 + rr - 1) * 32], knw = rw[(18 + rr + 1) * 32];
    const unsigned v0w = rw[(36 + rr) * 32], vpw = rw[(36 + rr - 1) * 32], vnw = rw[(36 + rr + 1) * 32];
    const unsigned eww = rw[(54 + rr - 1) * 32], eEw = rw[(54 + rrE - 1) * 32], aaw = rw[(70 + rr - 1) * 32];
    float cum0 = 0.f, cum1 = 0.f;
#pragma unroll
    for (int sp = 0; sp < S0; ++sp) { cum0 += bflo(pe[sp]); cum1 += bfhi(pe[sp]); }
    if (half) { cum0 += bflo(eEw); cum1 += bfhi(eEw); }
    const f32x2 r0 = {bflo(r0w), bfhi(r0w)}, rp = {bflo(rpw), bfhi(rpw)}, rn = {bflo(rnw), bfhi(rnw)};
    const f32x2 k0 = {bflo(k0w), bfhi(k0w)}, kp = {bflo(kpw), bfhi(kpw)}, kn = {bflo(knw), bfhi(knw)};
    const f32x2 v0 = {bflo(v0w), bfhi(v0w)}, vp = {bflo(vpw), bfhi(vpw)}, vn = {bflo(vnw), bfhi(vnw)};
    const f32x2 rs = r0 + K.mp_r * (rp - r0) + K.mn_r * (rn - r0), kx = k0 + K.mp_k * (kp - k0) + K.mn_k * (kn - k0), vv = v0 + K.mp_v * (vp - v0) + K.mn_v * (vn - v0);
    const f32x2 kkr = kx * K.kkw;
    float n2 = kkr.x * kkr.x + kkr.y * kkr.y;
    n2 = allred16(n2);
    { const auto r16 = __builtin_amdgcn_permlane16_swap(__float_as_uint(n2), __float_as_uint(n2), false, false); n2 = __uint_as_float(r16[0]) + __uint_as_float(r16[1]); }
    const float rn2 = __builtin_amdgcn_rsqf(fmaxf(n2, 1e-24f));
    const f32x2 kk = kkr * rn2, ew = {bflo(eww), bfhi(eww)}, aa = {bflo(aaw), bfhi(aaw)};
    const f32x2 cA = {cum0, cum1}, cB = cA + ew;
    f32x2 Lp, Lt, Li; Lp.x = __expf(-cA.x); Lp.y = __expf(-cA.y); Lt.x = __expf(-cB.x); Lt.y = __expf(-cB.y); Li.x = __expf(cB.x); Li.y = __expf(cB.y);
    const f32x2 av = Lp * kk, bv = kk * aa * Li, cv = kx * ((aa - 1.0f) * K.kaw + 1.0f) * Li, qv = rs * Lt;
    const unsigned aw_ = pk2c(av.x, av.y), bw_ = pk2c(bv.x, bv.y), cw_ = pk2c(cv.x, cv.y), qw_ = pk2c(qv.x, qv.y), vw_ = pk2c(vv.x, vv.y);
    LAS unsigned* m32 = (LAS unsigned*)Mn + cp;
    m32[0 * 576 + s * 36] = aw_; m32[1 * 576 + s * 36] = bw_; m32[2 * 576 + s * 36] = cw_; m32[3 * 576 + s * 36] = qw_;
    m32[4 * 576 + s * 36] = vw_;
    if (s == CS - 1) *(LAS f32x2*)((LAS float*)(Mn + 11520) + 2 * cp) = Lt;
}
__device__ __forceinline__ void p3_scan(Frame& F) {
    constexpr int CS = 16, NC = SEQL / CS;
    constexpr int MP = 144;
    constexpr int PAR = 11776;
    constexpr int O_SB = 3 * PAR;
    constexpr int O_SM = O_SB + 9216;
    constexpr int O_NF = O_SM + 4096;
    constexpr int O_YB = O_NF + 1024;
    constexpr int O_RAW = O_YB + 8192;
    constexpr int RAWB = (3 * 18 + 16 + 16) * 128;
    static_assert(O_RAW + 4 * RAWB <= 131072, "scan LDS");
    LAS unsigned char* L = F.lds;
    const int lane = F.lane, w = F.wave, g = lane >> 4, c = lane & 15, tid = F.tid;
    for (int chain = blockIdx.x; chain < 256; chain += F.G) {
        const int dir = chain >> 7, b = (chain >> 4) & 7, h = chain & 15;
        const int ch = h * 64 + lane;
        const float mp_r = F.mu_prev[ch], mn_r = F.mu_next[ch], mp_k = F.mu_prev[1024 + ch], mn_k = F.mu_next[1024 + ch], mp_v = F.mu_prev[2048 + ch], mn_v = F.mu_next[2048 + ch];
        const float kkw = F.k_k[ch], kaw = F.k_a[ch];
        Conv2C K2; { const int c2 = h * 64 + 2 * (lane & 31);
            K2.mp_r = *(const f32x2*)(F.mu_prev + c2); K2.mn_r = *(const f32x2*)(F.mu_next + c2); K2.mp_k = *(const f32x2*)(F.mu_prev + 1024 + c2); K2.mn_k = *(const f32x2*)(F.mu_next + 1024 + c2);
            K2.mp_v = *(const f32x2*)(F.mu_prev + 2048 + c2); K2.mn_v = *(const f32x2*)(F.mu_next + 2048 + c2); K2.kkw = *(const f32x2*)(F.k_k + c2); K2.kaw = *(const f32x2*)(F.k_a + c2); }
        const bf16* EWd = F.H + (size_t)dir * T_TOK * 1024 + (size_t)b * SEQL * 1024 + h * 64;
        const bf16* ARd = F.AR + (size_t)dir * T_TOK * 1024 + (size_t)b * SEQL * 1024 + h * 64;
        const bf16* Pb = F.P + (size_t)b * SEQL * PC + h * 64;
        const bf16* l_ptr[2]; int l_t[2]; int l_step[2]; bool l_on[2], l_chk[2]; unsigned l_dst[2];
#pragma unroll
        for (int sl = 0; sl < 2; ++sl) { const int item = sl == 0 ? tid : ((lane < 22) ? 512 + 22 * w + lane : 1 << 20); const int tlo0 = dir ? (SEQL - CS) : 0;
            l_dst[sl] = (unsigned)item * 16u;
            if (item < 432) { const int arr = item / 144, rem = item - arr * 144, rr = rem >> 3, seg = rem & 7; l_on[sl] = true; l_chk[sl] = true; l_t[sl] = tlo0 - 1 + rr;
                l_ptr[sl] = Pb + (ptrdiff_t)(tlo0 - 1 + rr) * PC + arr * 1024 + seg * 8; l_step[sl] = (dir ? -CS : CS) * PC; }
            else if (item < 688) { const int k2 = item >= 560, rem = item - (k2 ? 560 : 432), rr = rem >> 3, seg = rem & 7; l_on[sl] = true; l_chk[sl] = false; l_t[sl] = 0;
                l_ptr[sl] = (k2 ? ARd : EWd) + (ptrdiff_t)(tlo0 + rr) * 1024 + seg * 8; l_step[sl] = (dir ? -CS : CS) * 1024; }
            else { l_on[sl] = false; l_chk[sl] = false; l_t[sl] = 0; l_ptr[sl] = Pb; l_step[sl] = 0; } }
        const unsigned dma0 = (unsigned)(size_t)(L + O_RAW) + (unsigned)(w * 64) * 16u, dma1 = (unsigned)(size_t)(L + O_RAW) + (unsigned)(512 + 22 * w) * 16u;
        f32x4 st[4]; st[0] = (f32x4){0.f, 0.f, 0.f, 0.f}; st[1] = st[0]; st[2] = st[0]; st[3] = st[0];
        __syncthreads();
        for (int i = tid; i < 9216 / 4; i += 512) ((LAS unsigned*)(L + O_SB))[i] = 0u;
        for (int ci = -4; ci < NC; ++ci) {
            LAS unsigned char* M = L + ((ci + 6) % 3) * PAR;
            LAS unsigned char* SMc = L + O_SM + (ci & 1) * 2048;
            v2u yv = (v2u){0u, 0u}; GAS v2u* yp = nullptr;
            if (ci >= 1 && tid < 256) { const LAS float* yb = (const LAS float*)(L + O_YB + ((ci - 1) & 1) * 4096); const int s = tid >> 4, i4 = (tid & 15) * 4; const int stp = (ci - 1) * CS + s; const int t = dir ? (SEQL - 1 - stp) : stp;
                const f32x4 yf = *(const LAS f32x4*)(yb + s * 64 + i4); yv = (v2u){pk2c(yf.x, yf.y), pk2c(yf.z, yf.w)}; yp = (GAS v2u*)((bf16*)F.Y + ((size_t)dir * T_TOK + (size_t)b * SEQL + t) * 1024 + h * 64 + i4);
                *yp = yv; }
            const int cl = ci + 4; const bool doload = cl < NC;
            if (doload) { const unsigned stg = (unsigned)((cl & 3) * RAWB);
#pragma unroll
                for (int sl = 0; sl < 2; ++sl) {
                    if (l_on[sl]) {
                        if (!l_chk[sl] || (unsigned)l_t[sl] < (unsigned)SEQL) { if (sl) glds16s_nt(l_ptr[sl], dma1 + stg); else glds16s(l_ptr[sl], dma0 + stg); }
                        else *(LAS v4u*)(L + O_RAW + stg + l_dst[sl]) = (v4u){0u, 0u, 0u, 0u}; }
                    l_ptr[sl] += l_step[sl]; l_t[sl] += dir ? -CS : CS; } }
            if (w >= 4) {
                if (ci >= 0) {
                    const int n = w - 4;
                    const LAS float* Lc = (const LAS float*)(M + 11520);
                    const LAS unsigned char* trb = M + (4 * g + (c >> 2)) * MP + (c & 3) * 8;
                    v2u bB[4], bC[4]; f32x4 lc[4];
#pragma unroll
                    for (int jt = 0; jt < 4; ++jt) { bB[jt] = vtr2(trb + 1 * 2304 + 32 * jt); bC[jt] = vtr2(trb + 2 * 2304 + 32 * jt); lc[jt] = *(const LAS f32x4*)(Lc + 16 * jt + 4 * g); }
                    const v2u vtw = vtr2(trb + 4 * 2304 + 32 * n);
                    f32x4 g1t = (f32x4){0.f, 0.f, 0.f, 0.f}, qst = g1t;
                    const LAS unsigned char* Sb = L + O_SB + (16 * n + c) * MP + 16 * g;
#pragma unroll
                    for (int ks = 0; ks < 2; ++ks) { const bf16x8 sv = ld16(Sb + 64 * ks);
                        g1t = __builtin_amdgcn_mfma_f32_16x16x32_bf16(ld16(M + 0 * 2304 + c * MP + 16 * g + 64 * ks), sv, g1t, 0, 0, 0);
                        qst = __builtin_amdgcn_mfma_f32_16x16x32_bf16(ld16(M + 3 * 2304 + c * MP + 16 * g + 64 * ks), sv, qst, 0, 0, 0); }
                    const bf16x8 vt = __builtin_bit_cast(bf16x8, (v4u){vtw.x, vtw.y, 0u, 0u});
                    const f32x4 w1t = __builtin_amdgcn_mfma_f32_16x16x32_bf16(ld8z(SMc + 0 + c * 32 + g * 8), vt, g1t, 0, 0, 0);
                    const f32x4 ut = __builtin_amdgcn_mfma_f32_16x16x32_bf16(ld8z(SMc + 1536 + c * 32 + g * 8), pack4z(w1t), (f32x4){0.f, 0.f, 0.f, 0.f}, 0, 0, 0);
                    f32x4 yt = __builtin_amdgcn_mfma_f32_16x16x32_bf16(ld8z(SMc + 512 + c * 32 + g * 8), pack4z(ut), qst, 0, 0, 0);
                    yt = __builtin_amdgcn_mfma_f32_16x16x32_bf16(ld8z(SMc + 1024 + c * 32 + g * 8), vt, yt, 0, 0, 0);
                    LAS float* yb = (LAS float*)(L + O_YB + (ci & 1) * 4096);
#pragma unroll
                    for (int r = 0; r < 4; ++r) yb[(4 * g + r) * 64 + 16 * n + c] = yt[r];
                    const bf16x8 av = __builtin_bit_cast(bf16x8, (v4u){pk2c(ut.x, ut.y), pk2c(ut.z, ut.w), vtw.x, vtw.y});
#pragma unroll
                    for (int jt = 0; jt < 4; ++jt) {
                        f32x4 ns = __builtin_amdgcn_mfma_f32_16x16x32_bf16(__builtin_bit_cast(bf16x8, (v4u){bB[jt].x, bB[jt].y, bC[jt].x, bC[jt].y}), av, st[jt], 0, 0, 0);
                        ns = ns * lc[jt]; st[jt] = ns;
                        *(LAS v2u*)(L + O_SB + (16 * n + c) * MP + (16 * jt + 4 * g) * 2) = (v2u){pk2c(ns.x, ns.y), pk2c(ns.z, ns.w)}; }
                }
            } else if (ci + 1 >= 0 && ci + 1 < NC) {
                const LAS unsigned char* Mg = L + ((ci + 4) % 3) * PAR;
                LAS unsigned char* SMn = L + O_SM + ((ci + 1) & 1) * 2048;
                const LAS unsigned char* Lm = Mg + ((w & 1) ? 2 : 1) * 2304;
                const LAS unsigned char* Rm = Mg + ((w & 2) ? 3 : 0) * 2304;
                f32x4 x = (f32x4){0.f, 0.f, 0.f, 0.f};
#pragma unroll
                for (int ks = 0; ks < 2; ++ks) x = __builtin_amdgcn_mfma_f32_16x16x32_bf16(ld16(Lm + c * MP + 16 * g + 64 * ks), ld16(Rm + c * MP + 16 * g + 64 * ks), x, 0, 0, 0);
#pragma unroll
                for (int r = 0; r < 4; ++r) { const int tau = 4 * g + r; const bool keep = (w < 2) ? (tau < c) : (tau <= c); x[r] = keep ? x[r] : 0.f; }
                if (w == 0) {
#if SCAN_INV_MFMA
#define MM(Z, Y) __builtin_amdgcn_mfma_f32_16x16x32_bf16(pack4z(Z), pack4z(Y), (f32x4){0.f, 0.f, 0.f, 0.f}, 0, 0, 0)
                    f32x4 nt = (f32x4){0.f, 0.f, 0.f, 0.f};
#pragma unroll
                    for (int ks = 0; ks < 2; ++ks) nt = __builtin_amdgcn_mfma_f32_16x16x32_bf16(ld16(Rm + c * MP + 16 * g + 64 * ks), ld16(Lm + c * MP + 16 * g + 64 * ks), nt, 0, 0, 0);
                    f32x4 id;
#pragma unroll
                    for (int r = 0; r < 4; ++r) { nt[r] = (c < 4 * g + r) ? nt[r] : 0.f; id[r] = (4 * g + r == c) ? 1.f : 0.f; }
                    const f32x4 n2 = MM(nt, x), n2t = MM(x, nt);
                    const f32x4 n4 = MM(n2t, n2), n4t = MM(n2, n2t);
                    const f32x4 n8 = MM(n4t, n4);
                    const f32x4 t1t = MM(id + n2, id - nt);
                    const f32x4 t2t = MM(id + n4, t1t);
                    const f32x4 inv = MM(t2t, id + n8);
#undef MM
                    *(LAS v2u*)(SMn + 1536 + c * 32 + g * 8) = (v2u){pk2c(-inv.x, -inv.y), pk2c(-inv.z, -inv.w)};
#else
                    LAS float* Nf = (LAS float*)(L + O_NF);
#pragma unroll
                    for (int r = 0; r < 4; ++r) Nf[(4 * g + r) * 16 + c] = x[r];
                    LDS_WAIT();
                    float nrow[16][16];
#pragma unroll
                    for (int t = 0; t < 15; ++t) {
#pragma unroll
                        for (int q4 = 0; q4 < 4; ++q4) { const f32x4 nv = *(const LAS f32x4*)(Nf + t * 16 + 4 * q4); nrow[t][4 * q4] = nv.x; nrow[t][4 * q4 + 1] = nv.y; nrow[t][4 * q4 + 2] = nv.z; nrow[t][4 * q4 + 3] = nv.w; } }
                    float xr[16];
#pragma unroll
                    for (int t = 0; t < 16; ++t) xr[t] = (c == t) ? 1.f : 0.f;
#pragma unroll
                    for (int t = 0; t < 15; ++t) {
#pragma unroll
                        for (int t2 = t + 1; t2 < 16; ++t2) xr[t2] -= xr[t] * nrow[t][t2];
                    }
                    LAS bf16* InvT = (LAS bf16*)(SMn + 1536);
                    if (lane < 16) {
#pragma unroll
                        for (int t = 0; t < 16; ++t) InvT[t * 16 + c] = (bf16)pk2c(-xr[t], 0.f);
                    }
#endif
                } else {
                    LAS unsigned char* XT = SMn + (w - 1) * 512;
                    *(LAS v2u*)(XT + c * 32 + g * 8) = (v2u){pk2c(x.x, x.y), pk2c(x.z, x.w)};
                }
            }
            if (ci + 2 >= 0 && ci + 2 < NC) {
                const int cc = ci + 2;
                const LAS unsigned char* rwp = L + O_RAW + (cc & 3) * RAWB;
                LAS unsigned char* Mn = L + ((ci + 5) % 3) * PAR;
                switch (w) { case 0: scan_convert2<0>(rwp, Mn, dir, lane, K2); break; case 1: scan_convert2<1>(rwp, Mn, dir, lane, K2); break; case 2: scan_convert2<2>(rwp, Mn, dir, lane, K2); break; case 3: scan_convert2<3>(rwp, Mn, dir, lane, K2); break;
                             case 4: scan_convert2<4>(rwp, Mn, dir, lane, K2); break; case 5: scan_convert2<5>(rwp, Mn, dir, lane, K2); break; case 6: scan_convert2<6>(rwp, Mn, dir, lane, K2); break; default: scan_convert2<7>(rwp, Mn, dir, lane, K2); break; }
            }
            asm volatile("" :: "v"(yv), "v"(yp));
            if (doload) asm volatile("s_waitcnt vmcnt(2)" ::: "memory");
            else asm volatile("s_waitcnt vmcnt(0)" ::: "memory");
            __syncthreads();
        }
        if (tid < 256) { const LAS float* yb = (const LAS float*)(L + O_YB + ((NC - 1) & 1) * 4096); const int s = tid >> 4, i4 = (tid & 15) * 4; const int stp = (NC - 1) * CS + s; const int t = dir ? (SEQL - 1 - stp) : stp;
            const f32x4 yf = *(const LAS f32x4*)(yb + s * 64 + i4);
            *(GAS v2u*)((bf16*)F.Y + ((size_t)dir * T_TOK + (size_t)b * SEQL + t) * 1024 + h * 64 + i4) = (v2u){pk2c(yf.x, yf.y), pk2c(yf.z, yf.w)}; }
    }
}

__device__ __forceinline__ f32x4 shifted4(const bf16* P, size_t row, int t, int col, f32x4 mp, f32x4 mn) {
    const bf16* p = P + row * PC + col;
    const v2u z2 = *(const GAS v2u*)p; v2u zp2 = (v2u){0u, 0u}, zn2 = (v2u){0u, 0u};
    if (t > 0) zp2 = *(const GAS v2u*)(p - PC);
    if (t < SEQL - 1) zn2 = *(const GAS v2u*)(p + PC);
    const f32x4 z = (f32x4){bflo(z2.x), bfhi(z2.x), bflo(z2.y), bfhi(z2.y)}, zp = (f32x4){bflo(zp2.x), bfhi(zp2.x), bflo(zp2.y), bfhi(zp2.y)}, zn = (f32x4){bflo(zn2.x), bfhi(zn2.x), bflo(zn2.y), bfhi(zn2.y)};
    return z + mp * (zp - z) + mn * (zn - z);
}
struct CRow { v2u yf, yb, af, ab, g, r0, rp, rn, k0, kp, kn, v0, vp, vn; };
__device__ __forceinline__ void combine_load(CRow& R, const Frame& F, int rowi, int c0) {
    const size_t row = (size_t)rowi; const int t = rowi & (SEQL - 1); const bool hp = t > 0, hn = t < SEQL - 1;
    R.yf = __builtin_nontemporal_load((const GAS v2u*)((const bf16*)F.Y + row * 1024 + c0)); R.yb = __builtin_nontemporal_load((const GAS v2u*)((const bf16*)F.Y + ((size_t)T_TOK + row) * 1024 + c0));
    R.af = __builtin_nontemporal_load((const GAS v2u*)(F.AR + row * 1024 + c0)); R.ab = __builtin_nontemporal_load((const GAS v2u*)(F.AR + ((size_t)T_TOK + row) * 1024 + c0)); R.g = __builtin_nontemporal_load((const GAS v2u*)(F.G16 + row * 1024 + c0));
    const bf16* p = F.P + row * PC + c0; const v2u z = (v2u){0u, 0u};
    R.r0 = *(const GAS v2u*)(p + COL_R); R.rp = hp ? *(const GAS v2u*)(p + COL_R - PC) : z; R.rn = hn ? *(const GAS v2u*)(p + COL_R + PC) : z;
    R.k0 = *(const GAS v2u*)(p + COL_K); R.kp = hp ? *(const GAS v2u*)(p + COL_K - PC) : z; R.kn = hn ? *(const GAS v2u*)(p + COL_K + PC) : z;
    R.v0 = *(const GAS v2u*)(p + COL_V); R.vp = hp ? *(const GAS v2u*)(p + COL_V - PC) : z; R.vn = hn ? *(const GAS v2u*)(p + COL_V + PC) : z;
}
__device__ __forceinline__ f32x4 up4(v2u w) { return (f32x4){bflo(w.x), bfhi(w.x), bflo(w.y), bfhi(w.y)}; }
__device__ __forceinline__ v2u combine_row(const CRow& R, f32x4 mp_r, f32x4 mn_r, f32x4 mp_k, f32x4 mn_k, f32x4 mp_v, f32x4 mn_v, f32x4 kaw, f32x4 rkw, f32x4 lw, f32x4 lb) {
    const f32x4 y = up4(R.yf) + up4(R.yb);
    const f32x4 r0 = up4(R.r0), k0 = up4(R.k0), v0 = up4(R.v0);
    const f32x4 r = r0 + mp_r * (up4(R.rp) - r0) + mn_r * (up4(R.rn) - r0), k = k0 + mp_k * (up4(R.kp) - k0) + mn_k * (up4(R.kn) - k0), v = v0 + mp_v * (up4(R.vp) - v0) + mn_v * (up4(R.vn) - v0);
    const float mu = allred16((y.x + y.y) + (y.z + y.w)) * (1.f / 64.f);
    const f32x4 d = y - mu;
    const float var = allred16((d.x * d.x + d.y * d.y) + (d.z * d.z + d.w * d.w)) * (1.f / 64.f);
    const f32x4 yn = d * __builtin_amdgcn_rsqf(var + 64e-5f) * lw + lb;
    const f32x4 am = (up4(R.af) + up4(R.ab)) * 0.5f;
    const f32x4 km = k * ((am - 1.0f) * kaw + 1.0f);
    const f32x4 pr = r * km * rkw;
    const float bs = allred16((pr.x + pr.y) + (pr.z + pr.w));
    const f32x4 o = (yn + v * bs) * up4(R.g);
    return (v2u){pk2c(o.x, o.y), pk2c(o.z, o.w)};
}
__device__ __forceinline__ void p5_combine(Frame& F) {
    const int gw = F.vcu * NWAVES + F.wave, NGW = F.G * NWAVES, lane = F.lane;
    bf16* MIX = F.H;
    const int q = gw & 3, c0 = q * 256 + lane * 4;
    const f32x4 mp_r = *(const f32x4*)(F.mu_prev + c0), mn_r = *(const f32x4*)(F.mu_next + c0), mp_k = *(const f32x4*)(F.mu_prev + 1024 + c0), mn_k = *(const f32x4*)(F.mu_next + 1024 + c0),
                mp_v = *(const f32x4*)(F.mu_prev + 2048 + c0), mn_v = *(const f32x4*)(F.mu_next + 2048 + c0), kaw = *(const f32x4*)(F.k_a + c0), rkw = *(const f32x4*)(F.r_k + c0),
                lw = *(const f32x4*)(F.lnx_w + c0), lb = *(const f32x4*)(F.lnx_b + c0);
    const int stride = NGW >> 2;
    for (int rowi = gw >> 2; rowi < T_TOK; rowi += 4 * stride) {
        CRow R[4]; int rw4[4]; bool ok4[4];
#pragma unroll
        for (int u = 0; u < 4; ++u) { rw4[u] = rowi + u * stride; ok4[u] = rw4[u] < T_TOK; combine_load(R[u], F, ok4[u] ? rw4[u] : rowi, c0); }
        v2u o4[4];
#pragma unroll
        for (int u = 0; u < 4; ++u) o4[u] = combine_row(R[u], mp_r, mn_r, mp_k, mn_k, mp_v, mn_v, kaw, rkw, lw, lb);
#pragma unroll
        for (int u = 0; u < 4; ++u) if (ok4[u]) *(GAS v2u*)(MIX + (size_t)rw4[u] * 2048 + c0) = o4[u];
    }
}

__device__ __forceinline__ unsigned max32(const unsigned (&k)[32]) {
    unsigned m[8];
#pragma unroll
    for (int i = 0; i < 8; ++i) m[i] = umax(umax(k[4 * i], k[4 * i + 1]), umax(k[4 * i + 2], k[4 * i + 3]));
    return umax(umax(umax(m[0], m[1]), umax(m[2], m[3])), umax(umax(m[4], m[5]), umax(m[6], m[7])));
}
__device__ __forceinline__ void p9_peer(Frame& F) {
    const int gw = F.vcu * NWAVES + F.wave, NGW = F.G * NWAVES, lane = F.lane;
    LAS unsigned* sel = (LAS unsigned*)(F.lds + F.wave * 4096);
    LAS unsigned* elist = sel + 256;
    LAS float* glist = (LAS float*)(sel + 384);
    LAS float* alist = (LAS float*)(sel + 512);
    const float* S = F.S;
    unsigned pab[7];
#pragma unroll
    for (int i = 0; i < 7; ++i) pab[i] = kStair[(lane & 7) * 7 + i];
    for (int tok = gw; tok < T_TOK; tok += NGW) {
      float o[32], h2f[32]; float inv_rstd2 = 0.f;
#pragma unroll
      for (int i = 0; i < 32; ++i) o[i] = 0.f;
      for (int rep = 0; rep < NREP(8); ++rep) {
        unsigned key[32], top[16];
        { const int g4 = lane >> 2, q4 = lane & 3;
          typedef _Float16 h8 __attribute__((ext_vector_type(8)));
          const GAS h8* sp = (const GAS h8*)((const _Float16*)S + (size_t)tok * 2048 + g4 * 128 + q4 * 32);
#pragma unroll
          for (int i = 0; i < 4; ++i) { const h8 v = __builtin_nontemporal_load(&sp[i]);
#pragma unroll
              for (int j = 0; j < 8; ++j) key[8 * i + j] = (f2sort((float)v[j]) & 0xFFFFFF80u) | (unsigned)(q4 * 32 + 8 * i + j); }
#pragma unroll
          for (int r = 0; r < 16; ++r) {
              unsigned m = max32(key);
              m = umax(m, dppu<0xB1>(m)); m = umax(m, dppu<0x4E>(m));
              top[r] = m;
#pragma unroll
              for (int i = 0; i < 32; ++i) key[i] = (key[i] == m) ? 0u : key[i];
          }
          if (q4 == 0) {
#pragma unroll
              for (int r = 0; r < 16; r += 4) *(LAS v4u*)(sel + g4 * 16 + r) = (v4u){top[r], top[r + 1], top[r + 2], top[r + 3]};
          }
        }
        LDS_WAIT();
        { const int hd = lane >> 3, q8 = lane & 7;
          const LAS unsigned* s1p = sel + (2 * hd) * 16; const LAS unsigned* s2p = sel + (2 * hd + 1) * 16;
          unsigned k7[7];
#pragma unroll
          for (int i = 0; i < 7; ++i) { const unsigned ab = pab[i]; const float sv = sort2f(s1p[(ab >> 4) & 15u] & 0xFFFFFF80u) + sort2f(s2p[ab & 15u] & 0xFFFFFF80u);
              k7[i] = (ab != 0xFFu) ? ((f2sort(sv) & 0xFFFFFF00u) | ab) : 0u; }
#pragma unroll
          for (int r = 0; r < 16; ++r) {
              unsigned m = umax(umax(umax(k7[0], k7[1]), umax(k7[2], k7[3])), umax(umax(k7[4], k7[5]), k7[6]));
              m = umax(m, dppu<0xB1>(m)); m = umax(m, dppu<0x4E>(m)); m = umax(m, dppu<0x141>(m));
              top[r] = m;
#pragma unroll
              for (int i = 0; i < 7; ++i) k7[i] = (k7[i] == m) ? 0u : k7[i];
          }
          const float v0 = sort2f(top[0] & 0xFFFFFF00u);
#pragma unroll
          for (int r = 0; r < 16; ++r) if (q8 == (r & 7)) { const unsigned ci = top[r] & 0xFFu; const unsigned e1 = s1p[ci >> 4] & 0x7Fu, e2 = s2p[ci & 15u] & 0x7Fu;
              elist[hd * 16 + r] = e1 * 128u + e2; glist[hd * 16 + r] = sort2f(top[r] & 0xFFFFFF00u) - v0; }
        }
        LDS_WAIT();
        { const GAS v2u* xr = (const GAS v2u*)((const bf16*)F.Y + (size_t)tok * DMODEL) + lane; v2u xw[8]; f32x4 xv[8]; float ss = 0.f;
#pragma unroll
          for (int m = 0; m < 8; ++m) xw[m] = __builtin_nontemporal_load(&xr[64 * m]);
#pragma unroll
          for (int m = 0; m < 8; ++m) xv[m] = (f32x4){bflo(xw[m].x), bfhi(xw[m].x), bflo(xw[m].y), bfhi(xw[m].y)};
#pragma unroll
          for (int i = 0; i < 8; ++i) ss += (xv[i].x * xv[i].x + xv[i].y * xv[i].y) + (xv[i].z * xv[i].z + xv[i].w * xv[i].w);
          inv_rstd2 = sqrtf(wave_sum(ss) * (1.f / DMODEL) + 1e-6f); const float rstd = 1.0f / inv_rstd2;
          const GAS f32x4* wr = (const GAS f32x4*)F.norm2_w + lane;
#pragma unroll
          for (int m = 0; m < 8; ++m) { const f32x4 wv = wr[64 * m]; const f32x4 a = xv[m];
              h2f[4 * m + 0] = a.x * rstd * wv.x; h2f[4 * m + 1] = a.y * rstd * wv.y; h2f[4 * m + 2] = a.z * rstd * wv.z; h2f[4 * m + 3] = a.w * rstd * wv.w; }
          const float g0 = __expf(glist[lane] * rstd), g1 = __expf(glist[64 + lane] * rstd);
          const float z0 = allred16(g0), z1 = allred16(g1);
          glist[lane] = g0 / z0; glist[64 + lane] = g1 / z1;
        }
        LDS_WAIT();
        for (int k0 = 0; k0 < 128; k0 += 8) {
            v4u ua[8]; v2u ub[8]; float usc[8];
#pragma unroll
            for (int j = 0; j < 8; ++j) { const unsigned e = (unsigned)__builtin_amdgcn_readfirstlane((int)elist[k0 + j]); const unsigned char* up = F.U8 + (size_t)e * 1536;
                ua[j] = *(const GAS v4u*)(up + lane * 16); ub[j] = *(const GAS v2u*)(up + 1024 + lane * 8); usc[j] = F.US[e]; }
            float dd[8];
#pragma unroll
            for (int j = 0; j < 8; ++j) { const f32x32 uf = __builtin_amdgcn_cvt_scalef32_pk32_f32_fp6((v6u){ua[j].x, ua[j].y, ua[j].z, ua[j].w, ub[j].x, ub[j].y}, usc[j]);
                f32x2 da = (f32x2){0.f, 0.f}, db = da;
#pragma unroll
                for (int m = 0; m < 8; ++m) { da = __builtin_elementwise_fma((f32x2){uf[4 * m], uf[4 * m + 1]}, (f32x2){h2f[4 * m], h2f[4 * m + 1]}, da);
                                              db = __builtin_elementwise_fma((f32x2){uf[4 * m + 2], uf[4 * m + 3]}, (f32x2){h2f[4 * m + 2], h2f[4 * m + 3]}, db); }
                dd[j] = (da.x + da.y) + (db.x + db.y); }
            float e4[4], f2[2];
#pragma unroll
            for (int j = 0; j < 4; ++j) { const auto rr = __builtin_amdgcn_permlane32_swap(__float_as_uint(dd[j]), __float_as_uint(dd[j + 4]), false, false); e4[j] = __uint_as_float(rr[0]) + __uint_as_float(rr[1]); }
#pragma unroll
            for (int j = 0; j < 2; ++j) { const auto rr = __builtin_amdgcn_permlane16_swap(__float_as_uint(e4[j]), __float_as_uint(e4[j + 2]), false, false); f2[j] = __uint_as_float(rr[0]) + __uint_as_float(rr[1]); }
            allred16x2(f2[0], f2[1]);
            { const int q = lane >> 4, i0 = k0 + 2 * (q & 1) + 4 * (q >> 1);
              const float a0 = gelu_f(f2[0]) * glist[i0], a1 = gelu_f(f2[1]) * glist[i0 + 1];
              if ((lane & 15) == 0) { alist[i0] = a0; alist[i0 + 1] = a1; } }
        }
        LDS_WAIT();
        for (int k0 = 0; k0 < 128; k0 += PEER_RIF) {
            v4u va[PEER_RIF]; v2u vb[PEER_RIF]; float ac[PEER_RIF], vsc[PEER_RIF];
#pragma unroll
            for (int j = 0; j < PEER_RIF; ++j) { const unsigned e = (unsigned)__builtin_amdgcn_readfirstlane((int)elist[k0 + j]); const unsigned char* vp = F.V8 + (size_t)e * 1536;
                va[j] = *(const GAS v4u*)(vp + lane * 16); vb[j] = *(const GAS v2u*)(vp + 1024 + lane * 8); ac[j] = alist[k0 + j]; vsc[j] = F.VS[e]; }
#pragma unroll
            for (int j = 0; j < PEER_RIF; ++j) { const f32x32 vf = __builtin_amdgcn_cvt_scalef32_pk32_f32_fp6((v6u){va[j].x, va[j].y, va[j].z, va[j].w, vb[j].x, vb[j].y}, vsc[j]); const float a = ac[j];
#pragma unroll
                for (int m = 0; m < 32; ++m) o[m] += a * vf[m]; }
        }
      }
      if (NREP(8) > 1) {
#pragma unroll
          for (int i = 0; i < 32; ++i) o[i] *= (1.0f / NREP(8));
      }
        { GAS f32x4* xr = (GAS f32x4*)(F.out + (size_t)tok * DMODEL) + lane; float ss = 0.f;
          { const GAS f32x4* w2r = (const GAS f32x4*)F.norm2_w + lane;
#pragma unroll
            for (int m = 0; m < 8; ++m) { const f32x4 w2 = w2r[64 * m];
                o[4 * m + 0] += h2f[4 * m + 0] * inv_rstd2 * __builtin_amdgcn_rcpf(w2.x); o[4 * m + 1] += h2f[4 * m + 1] * inv_rstd2 * __builtin_amdgcn_rcpf(w2.y);
                o[4 * m + 2] += h2f[4 * m + 2] * inv_rstd2 * __builtin_amdgcn_rcpf(w2.z); o[4 * m + 3] += h2f[4 * m + 3] * inv_rstd2 * __builtin_amdgcn_rcpf(w2.w); } }
#pragma unroll
          for (int i = 0; i < 32; ++i) ss += o[i] * o[i];
          const float rstd = 1.0f / sqrtf(wave_sum(ss) * (1.f / DMODEL) + 1e-6f);
          const GAS f32x4* wr = (const GAS f32x4*)F.normf_w + lane;
#pragma unroll
          for (int m = 0; m < 8; ++m) { const f32x4 wv = wr[64 * m];
              __builtin_nontemporal_store((f32x4){o[4 * m + 0] * rstd * wv.x, o[4 * m + 1] * rstd * wv.y, o[4 * m + 2] * rstd * wv.z, o[4 * m + 3] * rstd * wv.w}, &xr[64 * m]); }
        }
        LDS_WAIT();
    }
}

struct Args { const float* in[24]; float* out; unsigned char* ws; int ph_lo, ph_hi, li, pad; };
__global__ void __launch_bounds__(NWAVES * 64, 2) hybrid_fwd(Args args) {
    extern __shared__ __attribute__((aligned(16))) unsigned char lds[];
    Frame F;
    F.lds = (LAS unsigned char*)lds;
    F.MISC = (volatile LAS unsigned*)(F.lds + MISC_OFF);
    F.tid = threadIdx.x; F.lane = F.tid & 63; F.wave = __builtin_amdgcn_readfirstlane(F.tid >> 6);
    F.G = gridDim.x; { const int bx = blockIdx.x; F.vcu = (F.G % 8 == 0) ? (bx % 8) * (F.G / 8) + bx / 8 : bx; }
    unsigned char* ws = args.ws;
    F.ctl = (gu32*)(ws + WS_CTL);
    F.x = args.in[0]; F.w_in = args.in[1]; F.mu_prev = args.in[2]; F.mu_next = args.in[3]; F.w0 = args.in[4]; F.w2 = args.in[5]; F.a0 = args.in[6]; F.a2 = args.in[7]; F.g2 = args.in[8];
    F.k_k = args.in[9]; F.k_a = args.in[10]; F.r_k = args.in[11]; F.lnx_w = args.in[12]; F.lnx_b = args.in[13]; F.qnw = args.in[14]; F.knw = args.in[15]; F.w_out = args.in[16];
    F.norm1_w = args.in[17]; F.norm2_w = args.in[18]; F.w_pq = args.in[19]; F.sub_keys = args.in[20]; F.u_tab = args.in[21]; F.v_tab = args.in[22]; F.normf_w = args.in[23];
    F.out = args.out;
    F.ROPE = (float*)(ws + WS_ROPE);
    F.H1 = (bf16*)args.out; F.INVR = (float*)(ws + WS_ROPE + 512 * 1024);
    F.WinT = (bf16*)(ws + WS_WINT); F.WoutT = (bf16*)(ws + WS_WOUTT); F.WsT = (bf16*)(ws + WS_WST);
    F.w2T = (bf16*)(ws + WS_LORA); F.a2T = F.w2T + 2 * 1024 * 96; F.g2T = F.a2T + 2 * 1024 * 96;
    F.H = (bf16*)(ws + WS_H); F.P = (bf16*)(ws + WS_P); F.AR = (bf16*)(ws + WS_AR); F.G16 = (bf16*)(ws + WS_G); F.Y = (float*)(ws + WS_Y);
    F.U16 = (bf16*)(ws + WS_P); F.V16 = F.U16 + (size_t)16384 * 2048;
    F.U8 = ws + WS_TAB; F.V8 = F.U8 + (size_t)16384 * 2048; F.US = (float*)(F.V8 + (size_t)16384 * 2048); F.VS = F.US + 16384;
    F.S = (float*)(ws + WS_P);
    for (int u = F.tid; u < (LDS_BYTES - LDSCTL_OFF) / 4; u += NWAVES * 64) ((LAS unsigned*)(F.lds + LDSCTL_OFF))[u] = 0u;
    __syncthreads();
    const int lo = args.ph_lo, hi = args.ph_hi;
    const bool multi = (hi - lo) > 1;
    XcdBarrier bar; bar.bar = (unsigned*)(F.ctl + CW_BAR); bar.x = 0; bar.st = nullptr;
    if (multi) bar = xcd_barrier_post((unsigned*)(F.ctl + CW_BAR), F.MISC + 8);
#define IN(k) (lo <= (k) && (k) < hi)
#define SEAM(k) do { if (IN(k) && IN((k) + 1)) xcd_barrier(bar); } while (0)

    if (IN(0)) { for (int rep = 0; rep < NREP(0); ++rep) p0_prologue(F); SEAM(0); }
    if (IN(1)) {
        pg8::Gemm g{F.H1, F.WinT, T_TOK, PC, DMODEL}; pg8::StaticOrder S; S.init(T_TOK, PC, F.G, (int)blockIdx.x);
        pg8::EpiBf16<0> E{F.P, PC, nullptr, 0, 0, 1.f};
        for (int rep = 0; rep < NREP(1); ++rep) pg8::gemm_phase<pg8::EpiBf16<0>, pg8::StaticOrder, true, true>(F.lds, g, S, E);
        { const int nwg = (T_TOK / 256) * (PC / 256), rem = nwg % F.G; const int first = rem, nidle = rem ? F.G - rem : F.G;
          const int bx = (int)blockIdx.x;
          if (bx >= (rem ? first : 0)) {
              const int iw = (bx - (rem ? first : 0)) * NWAVES + F.wave, NIW = nidle * NWAVES;
              for (int r0 = 2 * iw; r0 < 32768; r0 += 2 * NIW) { f32x4 ta[8], tb[8]; tab_load(F, r0, F.lane, ta); tab_load(F, r0 + 1, F.lane, tb); tab_finish(F, r0, F.lane, ta); tab_finish(F, r0 + 1, F.lane, tb); }
          } }
        SEAM(1);
    }
    if (IN(2)) { for (int rep = 1; rep < NREP(2); ++rep) p2_prep<false>(F); p2_prep<true>(F); SEAM(2); }
    if (IN(3)) { for (int rep = 0; rep < NREP(3); ++rep) p3_scan(F); SEAM(3); }
    if (IN(4)) {
        const attn_body::AttnTensors AT{(const attn_body::bf16*)(F.P + COL_Q), (const attn_body::bf16*)(F.P + COL_KA), (const attn_body::bf16*)(F.P + COL_VA), (attn_body::bf16*)(F.H + 1024)};
        const attn_body::StaticOrder S((int)F.G, F.vcu);
        for (int rep = 0; rep < NREP(4); ++rep) attn_body::attn_phase<attn_body::StaticOrder>((char*)lds, AT, S);
        for (int rep = 0; rep < NREP(9); ++rep) p5_combine(F);
        SEAM(4);
    }
    if (IN(5)) {
        pg8::Gemm g{F.H, F.WoutT, T_TOK, DMODEL, DMODEL}; pg8::StaticOrder S; S.init(T_TOK, DMODEL, F.G, (int)blockIdx.x);
        pg8::EpiX2 E{DMODEL, (const pg8::bf16_t*)F.H1, F.INVR, F.norm1_w, (pg8::bf16_t*)F.Y};
        for (int rep = 0; rep < NREP(5); ++rep) pg8::gemm_phase<pg8::EpiX2, pg8::StaticOrder, true, true>(F.lds, g, S, E);
        SEAM(5);
    }
    if (IN(7)) {
        pg8::Gemm g{(const bf16*)F.Y, F.WsT, T_TOK, DMODEL, DMODEL}; pg8::StaticOrder S; S.init(T_TOK, DMODEL, F.G, (int)blockIdx.x);
        pg8::EpiF16P E{(_Float16*)F.S, DMODEL};
        for (int rep = 0; rep < NREP(7); ++rep) pg8::gemm_phase<pg8::EpiF16P, pg8::StaticOrder, true, true>(F.lds, g, S, E);
        SEAM(7);
    }
    if (IN(8)) { p9_peer(F); }
#undef IN
#undef SEAM
}

extern "C" void kernel_launch(void* const* d_in, const int* in_sizes, int n_in, void* d_out, int out_size, void* d_ws, size_t ws_size, hipStream_t stream) {
    static int grid = 0;
    if (grid == 0) {
        if (n_in != 24 || out_size != T_TOK * DMODEL || ws_size < WS_END) { fprintf(stderr, "kernel_launch: unexpected shapes (n_in %d, out %d, ws %zu); nothing launched\n", n_in, out_size, ws_size); grid = -1; return; }
        int dev = 0, cus = 0, per_cu = 0;
        if (hipGetDevice(&dev) != hipSuccess || hipDeviceGetAttribute(&cus, hipDeviceAttributeMultiprocessorCount, dev) != hipSuccess) { grid = -1; return; }
        if (hipFuncSetAttribute((const void*)hybrid_fwd, hipFuncAttributeMaxDynamicSharedMemorySize, LDS_BYTES) != hipSuccess) { fprintf(stderr, "kernel_launch: hipFuncSetAttribute failed\n"); grid = -1; return; }
        if (hipOccupancyMaxActiveBlocksPerMultiprocessor(&per_cu, (const void*)hybrid_fwd, NWAVES * 64, LDS_BYTES) != hipSuccess || per_cu < 1) fprintf(stderr, "kernel_launch: occupancy query reports %d\n", per_cu);
        (void)hipGetLastError();
        grid = cus;
    }
    if (grid < 0) return;
    (void)hipMemsetAsync((char*)d_ws + WS_CTL, 0, CTL_ZERO_BYTES, stream);
    Args a{};
    for (int i = 0; i < 24; ++i) a.in[i] = (const float*)d_in[i];
    a.out = (float*)d_out; a.ws = (unsigned char*)d_ws;
#if MK_ONE_LAUNCH
    a.ph_lo = 0; a.ph_hi = N_PHASES; a.li = 0;
    hipLaunchKernelGGL(hybrid_fwd, dim3(grid), dim3(NWAVES * 64), LDS_BYTES, stream, a);
#else
    for (int p = 0; p < N_PHASES; ++p) { a.ph_lo = p; a.ph_hi = p + 1; a.li = p; hipLaunchKernelGGL(hybrid_fwd, dim3(grid), dim3(NWAVES * 64), LDS_BYTES, stream, a); }
#endif
}
```

```cpp
#include <hip/hip_runtime.h>
#include <cstdio>
#include <cstdint>
namespace pg8 {
#define PG8_LAS __attribute__((address_space(3)))
typedef unsigned short bf16_t;
typedef short bf16x8 __attribute__((ext_vector_type(8)));
typedef float f32x4 __attribute__((ext_vector_type(4)));
typedef unsigned u32x4 __attribute__((ext_vector_type(4)));
constexpr int BM = 256, BK = 64, HALF = 128, HTB = HALF * BK * 2  , STAGE_BYTES = 8 * HTB, NXCD = 8, WGM = 8;

__host__ __device__ __forceinline__ int lds_byte(int r, int c) { const int st = (r >> 4) * 2 + (c >> 5), rr = r & 15, cc = c & 31, ob = rr * 64 + cc * 2; return st * 1024 + (ob ^ (((ob >> 9) & 1) << 5)); }
__host__ __device__ __forceinline__ void stage_rc(int b, int& R, int& C) { const int st = b / 1024, sb = b % 1024, swz = sb ^ (((sb >> 9) & 1) << 5); R = (st >> 1) * 16 + swz / 64; C = (st & 1) * 32 + (swz % 64) / 2; }
__host__ __device__ __forceinline__ int perm32(int rho) { const int n = rho >> 4, i = rho & 15; return 8 * (i >> 2) + 4 * n + (i & 3); }

struct Unit { int pm, pn; };
struct Gemm { const bf16_t* A; const bf16_t* Bt; int M, N, K; };

struct StaticOrder {
    int nM, nN, nwg, G, c;
    __host__ __device__ void init(int M, int N, int G_, int c_) { nM = M / BM; nN = N / BM; nwg = nM * nN; G = G_; c = c_; }
    __host__ __device__ bool next(int i, Unit& u) const {
        const long L = (long)i * G + c; if (L >= nwg) return false;
        int wgid = (int)L; { const int q = nwg / NXCD, r = nwg % NXCD, xcd = wgid % NXCD, off = wgid / NXCD; wgid = (xcd < r ? xcd * (q + 1) : r * (q + 1) + (xcd - r) * q) + off; }
        const int nig = WGM * nN, gid = wgid / nig, fm = gid * WGM, gsz = (nM - fm) < WGM ? (nM - fm) : WGM;
        u.pm = fm + ((wgid % nig) % gsz); u.pn = (wgid % nig) / gsz; return true;
    }
    __device__ __forceinline__ void a_ready(const Unit&) const {}
    __device__ __forceinline__ void done(const Unit&) const {}
};

__device__ __forceinline__ unsigned cvt_pk_bf16(float lo, float hi) { unsigned r; asm volatile("v_cvt_pk_bf16_f32 %0, %1, %2" : "=v"(r) : "v"(lo), "v"(hi)); return r; }
typedef float f32x2 __attribute__((ext_vector_type(2)));
__device__ __forceinline__ f32x2 gelu_pk(f32x2 v) {
    const f32x2 av = __builtin_elementwise_abs(v), d = av * 0.2316418882f + 1.0f;
    f32x2 t; t.x = __builtin_amdgcn_rcpf(d.x); t.y = __builtin_amdgcn_rcpf(d.y);
    f32x2 q = t * 0.5307027145f + (-0.7265760135f); q = q * t + 0.7107068705f; q = q * t + (-0.142248368f); q = q * t + 0.127414796f; q = q * t;
    const f32x2 s = (v * v) * (-0.72134752044f);
    f32x2 e; e.x = __builtin_amdgcn_exp2f(s.x); e.y = __builtin_amdgcn_exp2f(s.y);
    const f32x2 m = v * (q * e), r = v - m;
    f32x2 o; o.x = v.x < 0.f ? m.x : r.x; o.y = v.y < 0.f ? m.y : r.y; return o;
}

template <int ACT  > struct EpiBf16 {
    static constexpr bool PERM = true, AFTER_DRAIN = false; static_assert(ACT == 0 || ACT == 1, "EpiBf16: ACT is 0 (none) or 1 (gelu_pk)");
    bf16_t* O; int ldc; const float* bias; int split_cols; size_t split_stride; float scale0;
    __device__ __forceinline__ void operator()(const f32x4 (&acc)[2][2][4][2], const Unit& u, int wr, int wc, int fr, int fq) const {
        const int row0 = u.pm * BM + wr * 64 + fr; int colt = u.pn * BM; bf16_t* base = O;
        float sc = 1.f; if (split_cols) { const int t = colt / split_cols; base += (size_t)t * split_stride; colt -= t * split_cols; if (t == 0) sc = scale0; }
        const int col0 = colt + wc * 32 + 8 * fq, bcol0 = u.pn * BM + wc * 32 + 8 * fq;
        f32x4 bv[2][2];
#pragma unroll
        for (int bj = 0; bj < 2; ++bj)
#pragma unroll
            for (int n = 0; n < 2; ++n) bv[bj][n] = bias ? *(const f32x4*)(bias + bcol0 + bj * HALF + 4 * n) : (f32x4){0.f, 0.f, 0.f, 0.f};
#pragma unroll
        for (int ai = 0; ai < 2; ++ai)
#pragma unroll
            for (int m = 0; m < 4; ++m) { bf16_t* rowp = base + (size_t)(row0 + ai * HALF + m * 16) * ldc + col0;
#pragma unroll
                for (int bj = 0; bj < 2; ++bj) { f32x4 v0 = acc[ai][bj][m][0] + bv[bj][0], v1 = acc[ai][bj][m][1] + bv[bj][1];
                    if (ACT == 1) { f32x2 a = gelu_pk((f32x2){v0[0], v0[1]}), b = gelu_pk((f32x2){v0[2], v0[3]}), c = gelu_pk((f32x2){v1[0], v1[1]}), d = gelu_pk((f32x2){v1[2], v1[3]});
                        v0 = (f32x4){a.x, a.y, b.x, b.y}; v1 = (f32x4){c.x, c.y, d.x, d.y}; }
                    v0 = v0 * sc; v1 = v1 * sc; u32x4 w; w.x = cvt_pk_bf16(v0[0], v0[1]); w.y = cvt_pk_bf16(v0[2], v0[3]); w.z = cvt_pk_bf16(v1[0], v1[1]); w.w = cvt_pk_bf16(v1[2], v1[3]);
                    *(u32x4*)(rowp + bj * HALF) = w; } }
    }
};
struct EpiF32Res {
    static constexpr bool PERM = false, AFTER_DRAIN = false;
    float* C; int ldc; const float* res;
    __device__ __forceinline__ void operator()(const f32x4 (&acc)[2][2][4][2], const Unit& u, int wr, int wc, int fr, int fq) const {
        const int row0 = u.pm * BM + wr * 64 + fr, col0 = u.pn * BM + wc * 32 + 4 * fq;
#pragma unroll
        for (int ai = 0; ai < 2; ++ai)
#pragma unroll
            for (int m = 0; m < 4; ++m) { const size_t off = (size_t)(row0 + ai * HALF + m * 16) * ldc + col0;
#pragma unroll
                for (int bj = 0; bj < 2; ++bj)
#pragma unroll
                    for (int n = 0; n < 2; ++n) { f32x4 v = acc[ai][bj][m][n]; if (res) v = v + *(const f32x4*)(res + off + bj * HALF + n * 16); *(f32x4*)(C + off + bj * HALF + n * 16) = v; } }
    }
};
struct EpiX2 {
    static constexpr bool PERM = true, AFTER_DRAIN = false;
    int ldc; const bf16_t* h1; const float* invr; const float* w; bf16_t* Xb;
    __device__ __forceinline__ void operator()(const f32x4 (&acc)[2][2][4][2], const Unit& u, int wr, int wc, int fr, int fq) const {
        const int row0 = u.pm * BM + wr * 64 + fr, col0 = u.pn * BM + wc * 32 + 8 * fq;
        f32x4 rw[2][2];
#pragma unroll
        for (int bj = 0; bj < 2; ++bj)
#pragma unroll
            for (int n = 0; n < 2; ++n) { const f32x4 wv = *(const f32x4*)(w + col0 + bj * HALF + 4 * n);
                rw[bj][n] = (f32x4){__builtin_amdgcn_rcpf(wv[0]), __builtin_amdgcn_rcpf(wv[1]), __builtin_amdgcn_rcpf(wv[2]), __builtin_amdgcn_rcpf(wv[3])}; }
#pragma unroll
        for (int ai = 0; ai < 2; ++ai)
#pragma unroll
            for (int m = 0; m < 4; ++m) { const int row = row0 + ai * HALF + m * 16; const size_t off = (size_t)row * ldc + col0; const float ir = invr[row];
#pragma unroll
                for (int bj = 0; bj < 2; ++bj) { const size_t o = off + bj * HALF; const u32x4 hw = __builtin_nontemporal_load((const u32x4*)(h1 + o));
                    const f32x4 x0 = (f32x4){__uint_as_float(hw.x << 16), __uint_as_float(hw.x & 0xffff0000u), __uint_as_float(hw.y << 16), __uint_as_float(hw.y & 0xffff0000u)};
                    const f32x4 x1 = (f32x4){__uint_as_float(hw.z << 16), __uint_as_float(hw.z & 0xffff0000u), __uint_as_float(hw.w << 16), __uint_as_float(hw.w & 0xffff0000u)};
                    const f32x4 v0 = acc[ai][bj][m][0] + x0 * ir * rw[bj][0], v1 = acc[ai][bj][m][1] + x1 * ir * rw[bj][1];
                    u32x4 w4; w4.x = cvt_pk_bf16(v0[0], v0[1]); w4.y = cvt_pk_bf16(v0[2], v0[3]); w4.z = cvt_pk_bf16(v1[0], v1[1]); w4.w = cvt_pk_bf16(v1[2], v1[3]);
                    *(u32x4*)(Xb + o) = w4; } }
    }
};
struct EpiF32P {
    static constexpr bool PERM = true, AFTER_DRAIN = false;
    float* C; int ldc;
    __device__ __forceinline__ void operator()(const f32x4 (&acc)[2][2][4][2], const Unit& u, int wr, int wc, int fr, int fq) const {
        const int row0 = u.pm * BM + wr * 64 + fr, col0 = u.pn * BM + wc * 32 + 8 * fq;
#pragma unroll
        for (int ai = 0; ai < 2; ++ai)
#pragma unroll
            for (int m = 0; m < 4; ++m) { const size_t off = (size_t)(row0 + ai * HALF + m * 16) * ldc + col0;
#pragma unroll
                for (int bj = 0; bj < 2; ++bj) { *(f32x4*)(C + off + bj * HALF) = acc[ai][bj][m][0]; *(f32x4*)(C + off + bj * HALF + 4) = acc[ai][bj][m][1]; } }
    }
};
struct EpiF16P {
    static constexpr bool PERM = true, AFTER_DRAIN = false;
    _Float16* C; int ldc;
    __device__ __forceinline__ void operator()(const f32x4 (&acc)[2][2][4][2], const Unit& u, int wr, int wc, int fr, int fq) const {
        typedef _Float16 h8 __attribute__((ext_vector_type(8)));
        const int row0 = u.pm * BM + wr * 64 + fr, col0 = u.pn * BM + wc * 32 + 8 * fq;
#pragma unroll
        for (int ai = 0; ai < 2; ++ai)
#pragma unroll
            for (int m = 0; m < 4; ++m) { const size_t off = (size_t)(row0 + ai * HALF + m * 16) * ldc + col0;
#pragma unroll
                for (int bj = 0; bj < 2; ++bj) { f32x4 v0 = acc[ai][bj][m][0], v1 = acc[ai][bj][m][1];
#pragma unroll
                    for (int j = 0; j < 4; ++j) { v0[j] = __builtin_amdgcn_fmed3f(v0[j], -60000.f, 60000.f); v1[j] = __builtin_amdgcn_fmed3f(v1[j], -60000.f, 60000.f); }
                    *(h8*)(C + off + bj * HALF) = (h8){(_Float16)v0[0], (_Float16)v0[1], (_Float16)v0[2], (_Float16)v0[3], (_Float16)v1[0], (_Float16)v1[1], (_Float16)v1[2], (_Float16)v1[3]}; } }
    }
};
template <class Epi, class Sched, bool ALIGN_EPI = false, bool SP2 = false>
__device__ __forceinline__ void gemm_phase(PG8_LAS unsigned char* lds, const Gemm g, const Sched& S, const Epi& E) {
    const int tid = threadIdx.x, wid = __builtin_amdgcn_readfirstlane(tid >> 6), lane = tid & 63, wr = wid >> 2, wc = wid & 3, fr = lane & 15, fq = lane >> 4;
    const int K = g.K, nt = K / BK;
    unsigned voffA[2], voffB[2];
#pragma unroll
    for (int i = 0; i < 2; ++i) { int R, C; stage_rc(tid * 16 + i * 8192, R, C); const int Rb = Epi::PERM ? ((R & ~31) + perm32(R & 31)) : R;
        voffA[i] = (unsigned)(R * K + C) * 2u; voffB[i] = (unsigned)(Rb * K + C) * 2u; }
    const size_t kstep = (size_t)(BK * 2);
    const size_t hstep = (size_t)HALF * K * 2;
    const size_t tstep = 2 * hstep;
    const unsigned ldsw = (unsigned)wid * 1024u;
    const int aoff = lds_byte(wr * 64 + fr, fq * 8), boff = lds_byte(wc * 32 + fr, fq * 8);
#define PG8_SA(b, h) (((b) * 2 + (h)) * HTB)
#define PG8_SB(b, h) ((4 + (b) * 2 + (h)) * HTB)
#define PG8_STAGE(bufoff, gbase, voff) do { _Pragma("unroll") for (int _i = 0; _i < 2; ++_i) \
        __builtin_amdgcn_global_load_lds((const unsigned*)((const char*)(gbase) + (voff)[_i]), (PG8_LAS unsigned*)(lds + (bufoff) + ldsw + _i * 8192), 16, 0, 0); } while (0)
#define PG8_LDA(dst, b, h) do { _Pragma("unroll") for (int m = 0; m < 4; ++m) _Pragma("unroll") for (int k = 0; k < 2; ++k) dst[m][k] = *(const PG8_LAS bf16x8*)(lds + PG8_SA(b, h) + aoff + m * 2048 + k * 1024); } while (0)
#define PG8_LDB(dst, b, h) do { _Pragma("unroll") for (int n = 0; n < 2; ++n) _Pragma("unroll") for (int k = 0; k < 2; ++k) dst[n][k] = *(const PG8_LAS bf16x8*)(lds + PG8_SB(b, h) + boff + n * 2048 + k * 1024); } while (0)
#define PG8_MMA(ai, bj, At, Bt) do { __builtin_amdgcn_s_setprio(1); _Pragma("unroll") for (int m = 0; m < 4; ++m) _Pragma("unroll") for (int n = 0; n < 2; ++n) _Pragma("unroll") for (int k = 0; k < 2; ++k) \
        acc[ai][bj][m][n] = __builtin_amdgcn_mfma_f32_16x16x32_bf16(Bt[n][k], At[m][k], acc[ai][bj][m][n], 0, 0, 0); __builtin_amdgcn_s_setprio(0); } while (0)
#define PG8_WAIT_V(n) asm volatile("s_waitcnt vmcnt(" #n ")" ::: "memory")
#define PG8_WAIT_L(n) asm volatile("s_waitcnt lgkmcnt(" #n ")" ::: "memory")
#define PG8_BAR __builtin_amdgcn_s_barrier()
#define PG8_SCHED __builtin_amdgcn_sched_barrier(0)
    Unit cur, nxt; int ui = 0;
    if (!S.next(0, cur)) return;
    f32x4 acc[2][2][4][2];
#pragma unroll
    for (int a = 0; a < 2; ++a)
#pragma unroll
        for (int b = 0; b < 2; ++b)
#pragma unroll
            for (int m = 0; m < 4; ++m)
#pragma unroll
                for (int n = 0; n < 2; ++n) acc[a][b][m][n] = (f32x4){0.f, 0.f, 0.f, 0.f};
    bf16x8 At[4][2], B0[2][2], B1[2][2];
    const char* cA = (const char*)g.A + (size_t)cur.pm * tstep; const char* cB = (const char*)g.Bt + (size_t)cur.pn * tstep;
    S.a_ready(cur);
    if constexpr (SP2) {
        PG8_STAGE(PG8_SB(0, 0), cB, voffB); PG8_STAGE(PG8_SB(0, 1), cB + hstep, voffB); PG8_STAGE(PG8_SA(0, 0), cA, voffA); PG8_STAGE(PG8_SA(0, 1), cA + hstep, voffA);
        if (wr == 1) PG8_BAR;
        PG8_WAIT_V(2); PG8_BAR;
        PG8_STAGE(PG8_SB(1, 0), cB + kstep, voffB); PG8_STAGE(PG8_SA(1, 0), cA + kstep, voffA); PG8_STAGE(PG8_SB(1, 1), cB + hstep + kstep, voffB);
        PG8_WAIT_V(6); PG8_BAR;
    } else {
        PG8_STAGE(PG8_SB(0, 0), cB, voffB); PG8_STAGE(PG8_SA(0, 0), cA, voffA); PG8_STAGE(PG8_SB(0, 1), cB + hstep, voffB); PG8_STAGE(PG8_SA(0, 1), cA + hstep, voffA);
        if (wr == 1) PG8_BAR;
        PG8_WAIT_V(4); PG8_BAR;
        PG8_STAGE(PG8_SB(1, 0), cB + kstep, voffB); PG8_STAGE(PG8_SA(1, 0), cA + kstep, voffA); PG8_STAGE(PG8_SB(1, 1), cB + hstep + kstep, voffB);
        PG8_WAIT_V(6); PG8_BAR;
    }
    for (;;) {
        const bool has_next = S.next(ui + 1, nxt);
        const char* nA = has_next ? (const char*)g.A + (size_t)nxt.pm * tstep : cA; const char* nB = has_next ? (const char*)g.Bt + (size_t)nxt.pn * tstep : cB;
        for (int t = 0; t < nt; t += 2) {
            const bool last = (t == nt - 2);
            const char* a1 = cA + (size_t)(t + 1) * kstep;
            const char* a2 = last ? nA : cA + (size_t)(t + 2) * kstep; const char* b2 = last ? nB : cB + (size_t)(t + 2) * kstep;
            const char* a3 = a2 + kstep; const char* b3 = b2 + kstep;
            if (last && has_next) S.a_ready(nxt);
            if constexpr (SP2) {
            PG8_LDB(B0, 0, 0); PG8_LDB(B1, 0, 1); PG8_SCHED; PG8_LDA(At, 0, 0); PG8_STAGE(PG8_SA(1, 1), a1 + hstep, voffA);
            PG8_WAIT_V(8); PG8_WAIT_L(0); PG8_BAR; PG8_MMA(0, 0, At, B0); PG8_MMA(0, 1, At, B1); PG8_BAR; PG8_SCHED;
            PG8_LDA(At, 0, 1); PG8_STAGE(PG8_SB(0, 0), b2, voffB); PG8_STAGE(PG8_SB(0, 1), b2 + hstep, voffB); PG8_STAGE(PG8_SA(0, 0), a2, voffA);
            PG8_WAIT_V(8); PG8_WAIT_L(0); PG8_BAR; PG8_MMA(1, 0, At, B0); PG8_MMA(1, 1, At, B1); PG8_BAR; PG8_SCHED;
            PG8_LDB(B0, 1, 0); PG8_LDB(B1, 1, 1); PG8_SCHED; PG8_LDA(At, 1, 0); PG8_STAGE(PG8_SA(0, 1), a2 + hstep, voffA);
            PG8_WAIT_V(8); PG8_WAIT_L(0); PG8_BAR; PG8_MMA(0, 0, At, B0); PG8_MMA(0, 1, At, B1); PG8_BAR; PG8_SCHED;
            PG8_LDA(At, 1, 1); PG8_STAGE(PG8_SB(1, 0), b3, voffB); PG8_STAGE(PG8_SB(1, 1), b3 + hstep, voffB); PG8_STAGE(PG8_SA(1, 0), a3, voffA);
            PG8_WAIT_V(8); PG8_WAIT_L(0); PG8_BAR; PG8_MMA(1, 0, At, B0); PG8_MMA(1, 1, At, B1); PG8_BAR; PG8_SCHED;
            } else {
            PG8_LDB(B0, 0, 0); PG8_SCHED; PG8_LDA(At, 0, 0); PG8_STAGE(PG8_SA(1, 1), a1 + hstep, voffA);
            PG8_WAIT_L(8); PG8_BAR; PG8_WAIT_L(0); PG8_MMA(0, 0, At, B0); PG8_BAR; PG8_SCHED;
            PG8_LDB(B1, 0, 1); PG8_STAGE(PG8_SB(0, 0), b2, voffB);
            PG8_BAR; PG8_WAIT_L(0); PG8_MMA(0, 1, At, B1); PG8_BAR;
            PG8_LDA(At, 0, 1); PG8_STAGE(PG8_SA(0, 0), a2, voffA);
            PG8_BAR; PG8_WAIT_L(0); PG8_MMA(1, 0, At, B0); PG8_BAR; PG8_SCHED;
            PG8_STAGE(PG8_SB(0, 1), b2 + hstep, voffB);
            PG8_WAIT_V(6); PG8_BAR; PG8_MMA(1, 1, At, B1); PG8_BAR;
            PG8_LDB(B0, 1, 0); PG8_SCHED; PG8_LDA(At, 1, 0); PG8_STAGE(PG8_SA(0, 1), a2 + hstep, voffA);
            PG8_WAIT_L(8); PG8_BAR; PG8_WAIT_L(0); PG8_MMA(0, 0, At, B0); PG8_BAR; PG8_SCHED;
            PG8_LDB(B1, 1, 1); PG8_STAGE(PG8_SB(1, 0), b3, voffB);
            PG8_BAR; PG8_WAIT_L(0); PG8_MMA(0, 1, At, B1); PG8_BAR;
            PG8_LDA(At, 1, 1); PG8_STAGE(PG8_SA(1, 0), a3, voffA);
            PG8_BAR; PG8_WAIT_L(0); PG8_MMA(1, 0, At, B0); PG8_BAR; PG8_SCHED;
            PG8_STAGE(PG8_SB(1, 1), b3 + hstep, voffB);
            PG8_WAIT_V(6); PG8_BAR; PG8_MMA(1, 1, At, B1); PG8_BAR;
            }
        }
        if constexpr (ALIGN_EPI) { if (wr == 0) PG8_BAR; }
        if constexpr (!Epi::AFTER_DRAIN) { E(acc, cur, wr, wc, fr, fq); S.done(cur); }
        if (!has_next) break;
#pragma unroll
        for (int a = 0; a < 2; ++a)
#pragma unroll
            for (int b = 0; b < 2; ++b)
#pragma unroll
                for (int m = 0; m < 4; ++m)
#pragma unroll
                    for (int n = 0; n < 2; ++n) acc[a][b][m][n] = (f32x4){0.f, 0.f, 0.f, 0.f};
        cur = nxt; cA = nA; cB = nB; ++ui;
        if constexpr (ALIGN_EPI) { if (wr == 1) PG8_BAR; }
    }
    PG8_WAIT_V(0);
    if constexpr (!ALIGN_EPI) { if (wr == 0) PG8_BAR; }
    PG8_BAR;
    if constexpr (Epi::AFTER_DRAIN) { E.fused(acc, cur, wr, wc, fr, fq, lds, wid, lane); S.done(cur); }
#undef PG8_SA
#undef PG8_SB
#undef PG8_STAGE
#undef PG8_LDA
#undef PG8_LDB
#undef PG8_MMA
#undef PG8_WAIT_V
#undef PG8_WAIT_L
#undef PG8_BAR
#undef PG8_SCHED
}
}
#include <hip/hip_bf16.h>
#include <cmath>
namespace attn_body {
using bf16=__hip_bfloat16;
using bf16x8=__attribute__((ext_vector_type(8)))short;
using s16x4=__attribute__((ext_vector_type(4)))short;
using f32x16=__attribute__((ext_vector_type(16)))float;
using u32x4=__attribute__((ext_vector_type(4)))unsigned;
constexpr int BATCH=8,NHEAD=16,SEQ=2048,D=64,PQ=5376,PO=2048;
constexpr int NW=8,QBLK=32,QB=QBLK*NW,KVBLK=64,NQB=SEQ/QB;
constexpr int ATTN_UNIT_ROWS=QB;
__device__ __forceinline__ int crow(int r,int hi){return (r&3)+8*(r>>2)+4*hi;}
#define SBAR() __builtin_amdgcn_sched_barrier(0)
constexpr int NSLOT=3, SLOTB=8192;
constexpr int LDS_K=0, LDS_V=NSLOT*SLOTB, LDS_WS=2*NSLOT*SLOTB, LDS_OST=LDS_WS+NW*64*4, LDS_BYTES=LDS_OST+NW*4096;
constexpr float C2=0.125f*1.4426950408889634f;
__device__ __forceinline__ void glds16(const void*gsrc,unsigned lds_dst){unsigned keep;
  asm volatile("s_mov_b32 %0, m0\n\ts_mov_b32 m0, %2\n\ts_nop 0\n\tglobal_load_lds_dwordx4 %1, off\n\ts_mov_b32 m0, %0":"=&s"(keep):"v"(gsrc),"s"(lds_dst):"memory");}
__device__ __forceinline__ float max3f(float a,float b,float c){float r;asm("v_max3_f32 %0, %1, %2, %3":"=v"(r):"v"(a),"v"(b),"v"(c));return r;}
__device__ __forceinline__ float max2f(float a,float b){float r;asm("v_max_f32_e32 %0, %1, %2":"=v"(r):"v"(a),"v"(b));return r;}
__device__ __forceinline__ float fadd_s(float a,float b){float r;asm("v_add_f32_e32 %0, %1, %2":"=v"(r):"v"(a),"v"(b));return r;}
__device__ __forceinline__ float fsub_s(float a,float b){float r;asm("v_sub_f32_e32 %0, %1, %2":"=v"(r):"v"(a),"v"(b));return r;}
typedef float f32x2_t __attribute__((ext_vector_type(2))); typedef __bf16 bf16x2_t __attribute__((ext_vector_type(2)));
__device__ __forceinline__ unsigned cvtpk_s(float lo,float hi){f32x2_t v={lo,hi};bf16x2_t b=__builtin_convertvector(v,bf16x2_t);return __builtin_bit_cast(unsigned,b);}
#define WAIT_BAR(N) asm volatile("s_waitcnt vmcnt(" #N ") lgkmcnt(0)\n\ts_barrier":::"memory")

__device__ __forceinline__ void qkt(f32x16&p0,f32x16&p1,const char*Kslot,const bf16x8*qr,const f32x16&negm,int r32,int hi){
  const char*kb=Kslot+hi*1024+r32*16;
  #pragma unroll
  for(int d0=0;d0<4;++d0){
    const bf16x8 b0=*reinterpret_cast<const bf16x8*>(kb+d0*2048);
    const bf16x8 b1=*reinterpret_cast<const bf16x8*>(kb+d0*2048+512);
    if(d0==0){p0=__builtin_amdgcn_mfma_f32_32x32x16_bf16(b0,qr[0],negm,0,0,0);p1=__builtin_amdgcn_mfma_f32_32x32x16_bf16(b1,qr[0],negm,0,0,0);}
    else{p0=__builtin_amdgcn_mfma_f32_32x32x16_bf16(b0,qr[d0],p0,0,0,0);p1=__builtin_amdgcn_mfma_f32_32x32x16_bf16(b1,qr[d0],p1,0,0,0);}}
}
typedef __attribute__((address_space(3))) const char* lds_cptr;
typedef short v4i16_t __attribute__((ext_vector_type(4)));
__device__ __forceinline__ void kload8(bf16x8*kf,lds_cptr kp){
  kf[0]=*(const __attribute__((address_space(3))) bf16x8*)(kp);      kf[1]=*(const __attribute__((address_space(3))) bf16x8*)(kp+512);
  kf[2]=*(const __attribute__((address_space(3))) bf16x8*)(kp+2048); kf[3]=*(const __attribute__((address_space(3))) bf16x8*)(kp+2560);
  kf[4]=*(const __attribute__((address_space(3))) bf16x8*)(kp+4096); kf[5]=*(const __attribute__((address_space(3))) bf16x8*)(kp+4608);
  kf[6]=*(const __attribute__((address_space(3))) bf16x8*)(kp+6144); kf[7]=*(const __attribute__((address_space(3))) bf16x8*)(kp+6656);
}
__device__ __forceinline__ void kload2(bf16x8*kf,lds_cptr kp,int j){ kf[2*j]=*(const __attribute__((address_space(3))) bf16x8*)(kp+j*2048); kf[2*j+1]=*(const __attribute__((address_space(3))) bf16x8*)(kp+j*2048+512); }
__device__ __forceinline__ s16x4 vtr(lds_cptr p){ return __builtin_bit_cast(s16x4,__builtin_amdgcn_ds_read_tr16_b64_v4i16((__attribute__((address_space(3))) v4i16_t*)p)); }
__device__ __forceinline__ float rowmax(const f32x16&p0,const f32x16&p1){
  float a=max3f(p0[0],p0[1],p1[0]),b=max3f(p0[2],p0[3],p1[1]);a=max3f(a,p1[2],p1[3]);
  #pragma unroll
  for(int r=4;r<16;r+=4){a=max3f(a,p0[r],p0[r+1]);b=max3f(b,p0[r+2],p0[r+3]);a=max3f(a,p1[r],p1[r+1]);b=max3f(b,p1[r+2],p1[r+3]);}
  const float m=max2f(a,b);
  auto rr=__builtin_amdgcn_permlane32_swap(__float_as_uint(m),__float_as_uint(m),false,false);
  return max2f(__uint_as_float(rr[0]),__uint_as_float(rr[1]));
}
__device__ __forceinline__ void pv(f32x16*o,int vb,bf16x8 pa0,bf16x8 pa1,bf16x8 pa2,bf16x8 pa3){
  #pragma unroll
  for(int d0=0;d0<2;++d0){s16x4 lo[4],hi[4];
    #pragma unroll
    for(int ks=0;ks<4;++ks){
      asm volatile("ds_read_b64_tr_b16 %0,%1 offset:%c2":"=&v"(lo[ks]):"v"(vb),"i"(d0*4096+ks*1024):"memory");
      asm volatile("ds_read_b64_tr_b16 %0,%1 offset:%c2":"=&v"(hi[ks]):"v"(vb),"i"(d0*4096+ks*1024+512):"memory");}
    asm volatile("s_waitcnt lgkmcnt(0)":::"memory");SBAR();
    #define PK(k) (bf16x8){lo[k][0],lo[k][1],lo[k][2],lo[k][3],hi[k][0],hi[k][1],hi[k][2],hi[k][3]}
    o[d0]=__builtin_amdgcn_mfma_f32_32x32x16_bf16(pa0,PK(0),o[d0],0,0,0);
    o[d0]=__builtin_amdgcn_mfma_f32_32x32x16_bf16(pa1,PK(1),o[d0],0,0,0);
    o[d0]=__builtin_amdgcn_mfma_f32_32x32x16_bf16(pa2,PK(2),o[d0],0,0,0);
    o[d0]=__builtin_amdgcn_mfma_f32_32x32x16_bf16(pa3,PK(3),o[d0],0,0,0);
    #undef PK
  }
}

#ifndef ATTN_STORE16
#define ATTN_STORE16(p,v) (*(u32x4*)(p)=(v))
#endif
template<int THRL> __device__ __forceinline__ void attn_unit(int b,int h,int qb,const bf16*Q,const bf16*__restrict__ K,const bf16*__restrict__ V,bf16*O,char*shm){
  const int tid=threadIdx.x,lane=tid&63,r32=lane&31,hi=lane>>5; const int wid=__builtin_amdgcn_readfirstlane(tid>>6);
  const long rowbase=(long)b*SEQ; const int q0=qb*QB;
  const bf16*Qw=Q+(rowbase+q0+wid*QBLK)*PQ+h*D;
  const bf16*Kh=K+rowbase*PQ+(h>>2)*D,*Vh=V+rowbase*PQ+(h>>2)*D;
  const unsigned lds0=(unsigned)(uintptr_t)shm;
  float*wsf=(float*)(shm+LDS_WS)+wid*64;
  const bf16*ksrc=Kh+(long)lane*PQ+wid*8;
  const bf16*vsrc=Vh+(long)(16*(wid&3)+(lane>>2))*PQ+(wid>>2)*32+(lane&3)*8;
  const unsigned kdst=lds0+LDS_K+wid*1024, vdst=lds0+LDS_V+wid*1024;
  #define DMA_K(t,slot) glds16(ksrc+(long)(t)*KVBLK*PQ,(unsigned)__builtin_amdgcn_readfirstlane(kdst+(slot)))
  #define DMA_V(t,slot) glds16(vsrc+(long)(t)*KVBLK*PQ,(unsigned)__builtin_amdgcn_readfirstlane(vdst+(slot)))
  const int vb0=(int)(lds0+LDS_V)+((lane>>4)&1)*32+(lane&3)*8+(4*hi+((lane&15)>>2))*64;
  const char*Kbase=shm+LDS_K; bf16x8 kf[8];
  const lds_cptr shm3=(lds_cptr)shm; const lds_cptr kp0=shm3+LDS_K+hi*1024+r32*16; const lds_cptr vp0=shm3+LDS_V+((lane>>4)&1)*32+(lane&3)*8+(4*hi+((lane&15)>>2))*64;
  const int NT=SEQ/KVBLK;
  DMA_K(0,0);DMA_V(0,0);DMA_K(1,SLOTB);
  bf16x8 qr[4];
  #pragma unroll
  for(int d0=0;d0<4;++d0)qr[d0]=*reinterpret_cast<const bf16x8*>(&Qw[(long)r32*PQ+d0*16+hi*8]);
  float mhat=0.f,l_reg=0.f;f32x16 o[2];o[0]=f32x16{};o[1]=f32x16{};f32x16 negm=f32x16{};asm volatile("":"+v"(negm));
  #define CMASK(P0,P1,t) do{}while(0)
  bool resc=false;
  #define START(P0,P1) do{ const float rm=rowmax(P0,P1); resc=false; \
    { const float dl=rm; mhat=fadd_s(mhat,dl); \
      _Pragma("unroll") for(int r=0;r<16;++r){P0[r]=fsub_s(P0[r],dl);P1[r]=fsub_s(P1[r],dl);} \
      _Pragma("unroll") for(int r=0;r<16;++r)negm[r]=-mhat; asm volatile("":"+v"(negm)); } \
    _Pragma("unroll") for(int r=0;r<16;++r)P0[r]=__builtin_amdgcn_exp2f(P0[r]); }while(0)
  #define RESC() do{ if(resc){ asm volatile("s_waitcnt lgkmcnt(0)":::"memory"); \
      _Pragma("unroll") for(int d_=0;d_<2;++d_) _Pragma("unroll") for(int r=0;r<16;++r)o[d_][r]*=wsf[crow(r,hi)]; } }while(0)
  f32x16 pA0,pA1,pB0,pB1;
  int sl_prev=0,sl_cur=0,sl_next=SLOTB;
  #define ROT() do{sl_prev=sl_cur;sl_cur=sl_next;sl_next=(sl_next==(NSLOT-1)*SLOTB)?0:sl_next+SLOTB;}while(0)
  DMA_K(2,2*SLOTB);
  WAIT_BAR(3);
  qkt(pA0,pA1,Kbase,qr,negm,r32,hi);asm volatile("s_nop 15\n\ts_nop 7":"+v"(pA0),"+v"(pA1));CMASK(pA0,pA1,0);
  START(pA0,pA1);
  _Pragma("unroll") for(int r=0;r<16;++r)pA1[r]=__builtin_amdgcn_exp2f(pA1[r]);
  WAIT_BAR(0);
  DMA_K(3,0);DMA_V(1,SLOTB);
  ROT();
  kload8(kf,kp0+sl_cur);
  WAIT_BAR(2);
  s16x4 vlo[8],vhi[8]; u32x4 pw0,pw1,pw2,pw3;
  #define PKW(P,B) cvtpk_s(P[B],P[B+1])
  #define PAF(k) __builtin_bit_cast(bf16x8,pw##k)
  #define VFR(i) (bf16x8){vlo[i][0],vlo[i][1],vlo[i][2],vlo[i][3],vhi[i][0],vhi[i][1],vhi[i][2],vhi[i][3]}
  #define PIN(x) asm volatile("":"+v"(x))
  #define MX3(a,b,c) __builtin_fmaxf(__builtin_fmaxf((a),(b)),(c))
  #define GAPA(MF,A0,A1,A2,A3,W0,W1,PW) do{ MF; sacc+=A0; sacc+=A1; sacc+=A2; sacc+=A3; PIN(sacc); W0; W1; PIN(PW); SBAR(); }while(0)
  #define EX(v) __builtin_amdgcn_exp2f(v)
  #define GAPB(MF,X,B) do{ MF; X[B]=EX(X[B]); X[B+1]=EX(X[B+1]); X[B+2]=EX(X[B+2]); X[B+3]=EX(X[B+3]); PIN(X); SBAR(); }while(0)
  #define VRD(i) do{ vlo[i]=vtr(vp_+(((i)>>2)*4096+((i)&3)*1024)); vhi[i]=vtr(vp_+(((i)>>2)*4096+((i)&3)*1024+512)); }while(0)
  #define KRD(G,j) do{ if(G){ kload2(kf,kp0+sl_next,j); SBAR(); } }while(0)
  #define STEP(C0,C1,P0,P1,t,GK,GV,GL) do{ SBAR(); \
    const lds_cptr vp_=vp0+sl_prev; \
    VRD(0); SBAR(); float sacc=(P0[0]+P0[1]); \
    GAPA(C0=__builtin_amdgcn_mfma_f32_32x32x16_bf16(kf[0],qr[0],negm,0,0,0), P0[2],P0[3],P0[4],P0[5],     pw0[0]=PKW(P0,0), pw0[1]=PKW(P0,2), pw0); \
    VRD(4); SBAR(); GAPA(C1=__builtin_amdgcn_mfma_f32_32x32x16_bf16(kf[1],qr[0],negm,0,0,0), P0[6],P0[7],P0[8],P0[9],     pw0[2]=PKW(P0,4), pw0[3]=PKW(P0,6), pw0); \
    VRD(1); SBAR(); GAPA(C0=__builtin_amdgcn_mfma_f32_32x32x16_bf16(kf[2],qr[1],C0,0,0,0),   P0[10],P0[11],P0[12],P0[13], pw1[0]=PKW(P0,8), pw1[1]=PKW(P0,10), pw1); \
    VRD(5); SBAR(); GAPA(C1=__builtin_amdgcn_mfma_f32_32x32x16_bf16(kf[3],qr[1],C1,0,0,0),   P0[14],P0[15],P1[0],P1[1],   pw1[2]=PKW(P0,12),pw1[3]=PKW(P0,14), pw1); \
    VRD(2); SBAR(); GAPA(C0=__builtin_amdgcn_mfma_f32_32x32x16_bf16(kf[4],qr[2],C0,0,0,0),   P1[2],P1[3],P1[4],P1[5],     pw2[0]=PKW(P1,0), pw2[1]=PKW(P1,2), pw2); \
    VRD(6); SBAR(); GAPA(C1=__builtin_amdgcn_mfma_f32_32x32x16_bf16(kf[5],qr[2],C1,0,0,0),   P1[6],P1[7],P1[8],P1[9],     pw2[2]=PKW(P1,4), pw2[3]=PKW(P1,6), pw2); \
    VRD(3); SBAR(); GAPA(C0=__builtin_amdgcn_mfma_f32_32x32x16_bf16(kf[6],qr[3],C0,0,0,0),   P1[10],P1[11],P1[12],P1[13], pw3[0]=PKW(P1,8), pw3[1]=PKW(P1,10), pw3); \
    VRD(7); SBAR(); GAPA(C1=__builtin_amdgcn_mfma_f32_32x32x16_bf16(kf[7],qr[3],C1,0,0,0),   P1[14],P1[15],0.f,0.f,       pw3[2]=PKW(P1,12),pw3[3]=PKW(P1,14), pw3); \
    l_reg+=sacc; \
    if(GK){DMA_K((t)+3,sl_cur);} if(GV){DMA_V((t)+1,sl_next);} \
    CMASK(C0,C1,t); \
    { float a=MX3(C0[0],C0[1],C1[0]),b=MX3(C0[2],C0[3],C1[1]); a=MX3(a,C1[2],C1[3]); \
      _Pragma("unroll") for(int r=4;r<16;r+=4){a=MX3(a,C0[r],C0[r+1]);b=MX3(b,C0[r+2],C0[r+3]);a=MX3(a,C1[r],C1[r+1]);b=MX3(b,C1[r+2],C1[r+3]);} \
      float rm=__builtin_fmaxf(a,b); { auto rr=__builtin_amdgcn_permlane32_swap(__float_as_uint(rm),__float_as_uint(rm),false,false); rm=__builtin_fmaxf(__uint_as_float(rr[0]),__uint_as_float(rr[1])); } \
      resc=false; \
      if(__builtin_expect(__any(rm>(float)THRL),0)){ const float dl=__builtin_fmaxf(rm,0.f); mhat+=dl; \
        _Pragma("unroll") for(int r=0;r<16;++r){C0[r]-=dl;C1[r]-=dl;} \
        _Pragma("unroll") for(int r=0;r<16;++r)negm[r]=-mhat; asm volatile("":"+v"(negm)); \
        const float f=__builtin_amdgcn_exp2f(-dl); l_reg*=f; if(hi==0)wsf[r32]=f; resc=true; } } \
    SBAR(); \
    GAPB(o[0]=__builtin_amdgcn_mfma_f32_32x32x16_bf16(PAF(0),VFR(0),o[0],0,0,0), C0,0); \
    GAPB(o[1]=__builtin_amdgcn_mfma_f32_32x32x16_bf16(PAF(0),VFR(4),o[1],0,0,0), C0,4); \
    KRD(GL,0); GAPB(o[0]=__builtin_amdgcn_mfma_f32_32x32x16_bf16(PAF(1),VFR(1),o[0],0,0,0), C0,8); \
    KRD(GL,1); GAPB(o[1]=__builtin_amdgcn_mfma_f32_32x32x16_bf16(PAF(1),VFR(5),o[1],0,0,0), C0,12); \
    KRD(GL,2); GAPB(o[0]=__builtin_amdgcn_mfma_f32_32x32x16_bf16(PAF(2),VFR(2),o[0],0,0,0), C1,0); \
    KRD(GL,3); GAPB(o[1]=__builtin_amdgcn_mfma_f32_32x32x16_bf16(PAF(2),VFR(6),o[1],0,0,0), C1,4); \
    GAPB(o[0]=__builtin_amdgcn_mfma_f32_32x32x16_bf16(PAF(3),VFR(3),o[0],0,0,0), C1,8); \
    GAPB(o[1]=__builtin_amdgcn_mfma_f32_32x32x16_bf16(PAF(3),VFR(7),o[1],0,0,0), C1,12); \
    }while(0)
  int t=1;
  #undef CMASK
  #define CMASK(P0,P1,t) do{}while(0)
  for(;t+5<NT;t+=2){
    STEP(pB0,pB1,pA0,pA1,t,true,true,true);     WAIT_BAR(2); RESC(); ROT();
    STEP(pA0,pA1,pB0,pB1,t+1,true,true,true);   WAIT_BAR(2); RESC(); ROT();
  }
  #undef CMASK
  #define CMASK(P0,P1,t) do{}while(0)
  #define ENDW(tt) do{ if((tt)+3<NT){WAIT_BAR(2);} else if((tt)+2<NT){WAIT_BAR(1);} else {WAIT_BAR(0);} }while(0)
  for(;t+1<NT;t+=2){
    STEP(pB0,pB1,pA0,pA1,t,(t+3<NT),(t+1<NT),(t+1<NT));       ENDW(t);   RESC(); ROT();
    STEP(pA0,pA1,pB0,pB1,t+1,(t+4<NT),(t+2<NT),(t+2<NT));     ENDW(t+1); RESC(); ROT();
  }
  STEP(pB0,pB1,pA0,pA1,NT-1,false,false,false); RESC();
  { float sacc=pB0[0]+pB0[1]; _Pragma("unroll") for(int r=2;r<16;++r)sacc+=pB0[r]; _Pragma("unroll") for(int r=0;r<16;++r)sacc+=pB1[r]; l_reg+=sacc;
    pw0=(u32x4){PKW(pB0,0),PKW(pB0,2),PKW(pB0,4),PKW(pB0,6)};pw1=(u32x4){PKW(pB0,8),PKW(pB0,10),PKW(pB0,12),PKW(pB0,14)};pw2=(u32x4){PKW(pB1,0),PKW(pB1,2),PKW(pB1,4),PKW(pB1,6)};pw3=(u32x4){PKW(pB1,8),PKW(pB1,10),PKW(pB1,12),PKW(pB1,14)};
    SBAR(); pv(o,vb0+sl_cur,PAF(0),PAF(1),PAF(2),PAF(3)); }
  #undef PKW
  #undef PAF
  #undef VFR
  #undef PIN
  #undef MX3
  #undef GAPA
  #undef GAPB
  #undef EX
  #undef VRD
  #undef KRD
  #undef STEP
  #undef ENDW
  {auto rr=__builtin_amdgcn_permlane32_swap(__float_as_uint(l_reg),__float_as_uint(l_reg),false,false);l_reg=__uint_as_float(rr[0])+__uint_as_float(rr[1]);}
  if(hi==0)wsf[32+r32]=l_reg;asm volatile("s_waitcnt lgkmcnt(0)":::"memory");
  float rli[16];
  #pragma unroll
  for(int r=0;r<16;++r)rli[r]=__builtin_amdgcn_rcpf(wsf[32+crow(r,hi)]);
  bf16*Ow=O+(rowbase+q0+wid*QBLK)*PO+h*D;
  { bf16*stg=(bf16*)(shm+LDS_OST)+wid*2048;
    #pragma unroll
    for(int r=0;r<16;++r){const int orow=crow(r,hi);
      #pragma unroll
      for(int d0=0;d0<2;++d0)stg[orow*64+d0*32+r32]=__float2bfloat16(o[d0][r]*rli[r]);}
    asm volatile("s_waitcnt lgkmcnt(0)":::"memory");
    #pragma unroll
    for(int i=0;i<4;++i){const int row=i*8+(lane>>3),ch=lane&7; const u32x4 v=*(const u32x4*)(stg+row*64+ch*8); ATTN_STORE16(Ow+(long)row*PO+ch*8,v);} }
  asm volatile("s_waitcnt lgkmcnt(0)\n\ts_barrier":::"memory");
  #undef DMA_K
  #undef DMA_V
  #undef CMASK
  #undef START
  #undef RESC
  #undef ROT
}
constexpr int ATTN_LDS_BYTES=LDS_BYTES;
struct AttnTensors { const bf16* Q; const bf16* K; const bf16* V; bf16* O; };
struct AttnUnit { int b; int h; int qb; };
struct StaticOrder {
  int vcu, G;
  __device__ __forceinline__ explicit StaticOrder(int grid,int v):vcu(v),G(grid){}
  __device__ __forceinline__ bool next(int i,AttnUnit&u)const{ const int id=vcu+i*G; if(id>=1024)return false; const int w=id&255, r=id>>8; const int bk=w>>3; u.b=bk>>2; u.h=(bk&3)*4+r; u.qb=w&7; return true; }
  __device__ __forceinline__ void a_ready(const AttnUnit&)const{}
  __device__ __forceinline__ void done(const AttnUnit&)const{}
};
template<class Sched,int THRL=8> __device__ __forceinline__ void attn_phase(char*lds,const AttnTensors&T,const Sched&S){
  AttnUnit u;
  for(int i=0;S.next(i,u);++i){ S.a_ready(u); attn_unit<THRL>(u.b,u.h,u.qb,T.Q,T.K,T.V,T.O,lds); S.done(u); }
}
#undef SBAR
#undef WAIT_BAR
}
constexpr int NWAVES = 8;
constexpr int T_TOK = 16384, SEQL = 2048, DMODEL = 2048, PC = 5376;
constexpr int COL_R = 0, COL_K = 1024, COL_V = 2048, COL_LORA = 3072, COL_Q = 3712, COL_KA = 4736, COL_VA = 4992;
#ifndef MK_ONE_LAUNCH
#define MK_ONE_LAUNCH 1
#endif
constexpr int N_PHASES = 9;
#ifndef REP_P
#define REP_P -1
#define REP_N 1
#endif
#define NREP(k) (((k) == REP_P) ? REP_N : 1)
#ifndef PEER_RIF
#define PEER_RIF 8
#endif
#ifndef SCAN_INV_MFMA
#define SCAN_INV_MFMA 1
#endif
constexpr size_t MiB = 1u << 20;
constexpr size_t WS_CTL = 0, CTL_ZERO_BYTES = 64 * 1024;
constexpr size_t WS_ROPE = 1 * MiB;
constexpr size_t WS_WINT = 2 * MiB, WS_WOUTT = 23 * MiB, WS_WST = 31 * MiB, WS_LORA = 39 * MiB;
constexpr size_t WS_H = 41 * MiB;
constexpr size_t WS_P = 105 * MiB;
constexpr size_t WS_AR = 273 * MiB, WS_G = 337 * MiB, WS_Y = 369 * MiB, WS_TAB = 433 * MiB, WS_END = 498 * MiB;
constexpr int CW_BAR = 4096;
constexpr int RING_BYTES = 131072, LDSCTL_OFF = RING_BYTES, MISC_OFF = LDSCTL_OFF + 320, LDS_BYTES = 147456;

#define GAS __attribute__((address_space(1)))
#define LAS __attribute__((address_space(3)))
typedef unsigned short bf16;
typedef unsigned v4u __attribute__((ext_vector_type(4)));
typedef unsigned v2u __attribute__((ext_vector_type(2)));
typedef float f32x4 __attribute__((ext_vector_type(4)));
typedef float f32x2 __attribute__((ext_vector_type(2)));
typedef float f32x16 __attribute__((ext_vector_type(16)));
typedef float f32x32 __attribute__((ext_vector_type(32)));
typedef unsigned v6u __attribute__((ext_vector_type(6)));
typedef short bf16x8 __attribute__((ext_vector_type(8)));
typedef __bf16 bf16x2v __attribute__((ext_vector_type(2)));
typedef GAS unsigned gu32;
#define RLX_AGENT __ATOMIC_RELAXED, __HIP_MEMORY_SCOPE_AGENT
#define LDS_WAIT() asm volatile("s_waitcnt lgkmcnt(0)" ::: "memory")
__device__ __forceinline__ unsigned f2bf(float f) { unsigned u = __builtin_bit_cast(unsigned, f); return (u + 0x7fffu + ((u >> 16) & 1u)) >> 16; }
__device__ __forceinline__ unsigned pk2(float lo, float hi) { return f2bf(lo) | (f2bf(hi) << 16); }
__device__ __forceinline__ unsigned pk2c(float lo, float hi) { const f32x2 v = {lo, hi}; const bf16x2v b = __builtin_convertvector(v, bf16x2v); return __builtin_bit_cast(unsigned, b); }
__device__ __forceinline__ float bf2f(unsigned short u) { return __uint_as_float((unsigned)u << 16); }
__device__ __forceinline__ float bflo(unsigned w) { return __uint_as_float(w << 16); }
__device__ __forceinline__ float bfhi(unsigned w) { return __uint_as_float(w & 0xffff0000u); }
__device__ __forceinline__ float sigmoid_f(float x) { return __builtin_amdgcn_rcpf(1.0f + __expf(-x)); }
__device__ __forceinline__ float tanh_f(float x) { return 1.0f - 2.0f * __builtin_amdgcn_rcpf(__expf(2.0f * x) + 1.0f); }
__device__ __forceinline__ float dot2bf(unsigned a, unsigned b, float acc) { return __builtin_amdgcn_fdot2_f32_bf16(__builtin_bit_cast(bf16x2v, a), __builtin_bit_cast(bf16x2v, b), acc, false); }
template <int CTRL> __device__ __forceinline__ float dppf(float x) { return __builtin_bit_cast(float, __builtin_amdgcn_mov_dpp(__builtin_bit_cast(int, x), CTRL, 0xf, 0xf, true)); }
template <int CTRL> __device__ __forceinline__ unsigned dppu(unsigned x) { return (unsigned)__builtin_amdgcn_mov_dpp((int)x, CTRL, 0xf, 0xf, true); }
__device__ __forceinline__ float allred16(float x) { x += dppf<0xB1>(x); x += dppf<0x4E>(x); x += dppf<0x141>(x); x += dppf<0x128>(x); return x; }
__device__ __forceinline__ float wave_sum(float v) {
    v += dppf<0xB1>(v); v += dppf<0x4E>(v); v += dppf<0x141>(v); v += dppf<0x140>(v);
    { const auto r = __builtin_amdgcn_permlane16_swap(__float_as_uint(v), __float_as_uint(v), false, false); v = __uint_as_float(r[0]) + __uint_as_float(r[1]); }
    { const auto r = __builtin_amdgcn_permlane32_swap(__float_as_uint(v), __float_as_uint(v), false, false); v = __uint_as_float(r[0]) + __uint_as_float(r[1]); }
    return v;
}
__device__ __forceinline__ void allred16x2(float& a, float& b) {
    asm("s_nop 1\n\t"
        "v_add_f32_dpp %0, %0, %0 quad_perm:[1,0,3,2] row_mask:0xf bank_mask:0xf\n\t"
        "v_add_f32_dpp %1, %1, %1 quad_perm:[1,0,3,2] row_mask:0xf bank_mask:0xf\n\t"
        "s_nop 0\n\t"
        "v_add_f32_dpp %0, %0, %0 quad_perm:[2,3,0,1] row_mask:0xf bank_mask:0xf\n\t"
        "v_add_f32_dpp %1, %1, %1 quad_perm:[2,3,0,1] row_mask:0xf bank_mask:0xf\n\t"
        "s_nop 0\n\t"
        "v_add_f32_dpp %0, %0, %0 row_half_mirror row_mask:0xf bank_mask:0xf\n\t"
        "v_add_f32_dpp %1, %1, %1 row_half_mirror row_mask:0xf bank_mask:0xf\n\t"
        "s_nop 0\n\t"
        "v_add_f32_dpp %0, %0, %0 row_ror:8 row_mask:0xf bank_mask:0xf\n\t"
        "v_add_f32_dpp %1, %1, %1 row_ror:8 row_mask:0xf bank_mask:0xf\n\t"
        "s_nop 0"
        : "+v"(a), "+v"(b));
}
__device__ __forceinline__ float wave_max(float v) {
    v = fmaxf(v, dppf<0xB1>(v)); v = fmaxf(v, dppf<0x4E>(v)); v = fmaxf(v, dppf<0x141>(v)); v = fmaxf(v, dppf<0x140>(v));
    { const auto r = __builtin_amdgcn_permlane16_swap(__float_as_uint(v), __float_as_uint(v), false, false); v = fmaxf(__uint_as_float(r[0]), __uint_as_float(r[1])); }
    { const auto r = __builtin_amdgcn_permlane32_swap(__float_as_uint(v), __float_as_uint(v), false, false); v = fmaxf(__uint_as_float(r[0]), __uint_as_float(r[1])); }
    return v;
}
__device__ __forceinline__ unsigned umax(unsigned a, unsigned b) { return a > b ? a : b; }
__device__ __forceinline__ unsigned f2sort(float f) { const unsigned u = __float_as_uint(f); return u ^ ((unsigned)((int)u >> 31) | 0x80000000u); }
__device__ __forceinline__ float sort2f(unsigned k) { const unsigned u = (k & 0x80000000u) ? (k ^ 0x80000000u) : ~k; return __uint_as_float(u); }
__device__ __forceinline__ float gelu_f(float v) {
    const float av = fabsf(v), t = __builtin_amdgcn_rcpf(av * 0.2316418882f + 1.0f);
    float q = t * 0.5307027145f + (-0.7265760135f); q = q * t + 0.7107068705f; q = q * t + (-0.142248368f); q = q * t + 0.127414796f; q = q * t;
    const float e = __builtin_amdgcn_exp2f((v * v) * (-0.72134752044f));
    const float m = v * (q * e);
    return v < 0.f ? m : v - m;
}

__device__ const unsigned char kStair[56] = {0, 1, 2, 3, 4, 5, 6, 7, 8, 9, 10, 11, 12, 13, 14, 15, 16, 17, 18, 19, 20, 21, 22, 23, 32, 33, 34, 35, 36, 48, 49, 50, 51, 64, 65, 66, 80, 81, 96, 97, 112, 113, 128, 144, 160, 176, 192, 208, 224, 240, 255, 255, 255, 255, 255, 255};
__device__ const double kRopeInv[16] = {1.0, 0.5623413251903491, 0.31622776601683794, 0.1778279410038923, 0.1, 0.05623413251903491, 0.031622776601683794, 0.01778279410038923,
                                        0.01, 0.005623413251903491, 0.0031622776601683794, 0.001778279410038923, 0.001, 0.0005623413251903491, 0.00031622776601683794, 0.0001778279410038923};

#define XB_TMO      128
#define XB_XCNT(j)  (256  + 64 * (j))
#define XB_XSUB(j)  (1280 + 64 * (j))
#define XB_XGEN(j)  (2304 + 64 * (j))
#define XB_TOP      3328
#define XB_TOPGEN   3392
#define XCD_BAR_WORDS 3456
#define XB_SPIN_CAP (1u << 18)

__device__ __forceinline__ unsigned xb_ld(unsigned* p)              { return __hip_atomic_load(p, __ATOMIC_RELAXED, __HIP_MEMORY_SCOPE_AGENT); }
__device__ __forceinline__ unsigned xb_add(unsigned* p, unsigned v) { return __hip_atomic_fetch_add(p, v, __ATOMIC_RELAXED, __HIP_MEMORY_SCOPE_AGENT); }
__device__ __forceinline__ unsigned xb_xcc_id() { return (unsigned)__builtin_amdgcn_s_getreg((3 << 11) | 20) & 0xFu; }
#define XB_SPIN(cond, bar) do { unsigned _sp = 0; while (cond) { __builtin_amdgcn_s_sleep(1); \
    if ((++_sp & 255u) == 0u) { if (xb_ld(&(bar)[XB_TMO])) break; if (_sp > XB_SPIN_CAP) { atomicAdd(&(bar)[XB_TMO], 1u); break; } } } } while (0)

struct XcdBarrier {
    unsigned* bar; unsigned x;
    volatile LAS unsigned* st;
};

__device__ __forceinline__ XcdBarrier xcd_barrier_post(unsigned* bar, volatile LAS unsigned* st) {
    XcdBarrier b; b.bar = bar; b.x = xb_xcc_id(); b.st = st;
    if (threadIdx.x == 0) (void)xb_add(&bar[XB_XCNT(b.x)], 1u);
    return b;
}
__device__ __forceinline__ void xcd_barrier_complete(unsigned* bar, unsigned x, unsigned& nloc, unsigned& nx) {
    const unsigned G = gridDim.x * gridDim.y * gridDim.z;
    unsigned sum, cnt, mine, sp = 0u;
    for (;;) {
        sum = 0u; cnt = 0u; mine = 0u;
#pragma unroll
        for (unsigned j = 0; j < 16; ++j) { const unsigned c = xb_ld(&bar[XB_XCNT(j)]); sum += c; cnt += (c > 0u) ? 1u : 0u; mine = (j == x) ? c : mine; }
        if (sum == G) break;
        __builtin_amdgcn_s_sleep(1);
        if ((++sp & 255u) == 0u) { if (xb_ld(&bar[XB_TMO])) break; if (sp > XB_SPIN_CAP) { atomicAdd(&bar[XB_TMO], 1u); break; } }
    }
    nloc = mine > 0u ? mine : 1u; nx = cnt > 0u ? cnt : 1u;
}

__device__ __forceinline__ void xcd_barrier(const XcdBarrier& b) {
    asm volatile("s_waitcnt vmcnt(0)" ::: "memory");
    __syncthreads();
    if (threadIdx.x == 0) {
        unsigned* bar = b.bar;
        __builtin_amdgcn_s_waitcnt(0);
        unsigned nloc = b.st[0], nx = b.st[1];
        if (nloc == 0u) { xcd_barrier_complete(bar, b.x, nloc, nx); b.st[0] = nloc; b.st[1] = nx; }
        const unsigned old = xb_add(&bar[XB_XSUB(b.x)], 1u);
        const unsigned gen = old / nloc;
        if (old + 1u == (gen + 1u) * nloc) {
            __builtin_amdgcn_fence(__ATOMIC_RELEASE, "agent");
            asm volatile("s_waitcnt vmcnt(0)" ::: "memory");
            const unsigned og = xb_add(&bar[XB_TOP], 1u);
            const unsigned tg = og / nx;
            if (og + 1u == (tg + 1u) * nx) xb_add(&bar[XB_TOPGEN], 1u);
            else XB_SPIN(xb_ld(&bar[XB_TOPGEN]) == tg, bar);
            __builtin_amdgcn_fence(__ATOMIC_ACQUIRE, "agent");
            xb_add(&bar[XB_XGEN(b.x)], 1u);
            asm volatile("s_waitcnt vmcnt(0)" ::: "memory");
        } else {
            XB_SPIN(xb_ld(&bar[XB_XGEN(b.x)]) == gen, bar);
            __builtin_amdgcn_fence(__ATOMIC_ACQUIRE, "agent");
            asm volatile("s_waitcnt vmcnt(0)" ::: "memory");
        }
    }
    __syncthreads();
}

struct Frame {
    LAS unsigned char* lds;
    volatile LAS unsigned* MISC;
    gu32* ctl;
    int tid, lane, wave;
    int vcu, G;
    const float *x, *w_in, *mu_prev, *mu_next, *w0, *w2, *a0, *a2, *g2, *k_k, *k_a, *r_k, *lnx_w, *lnx_b, *qnw, *knw, *w_out, *norm1_w, *norm2_w, *w_pq, *sub_keys, *u_tab, *v_tab, *normf_w;
    float* out;
    bf16 *WinT, *WoutT, *WsT, *w2T, *a2T, *g2T, *H1; float* INVR;
    bf16 *H, *P, *AR, *G16, *U16, *V16;
    float *Y, *ROPE, *S;
    unsigned char *U8, *V8; float *US, *VS;
};

__device__ __forceinline__ void p0_transpose_item(const float* W, int K, int N, bf16* WT, LAS float* scr, int item, int lane) {
    const int nblk = N / 32, kb = item / nblk, nb = item % nblk, k0 = 64 * kb, n0 = 32 * nb;
    float tv[32];
#pragma unroll
    for (int i = 0; i < 32; ++i) tv[i] = __builtin_nontemporal_load(&W[(size_t)(k0 + 2 * i + (lane >> 5)) * N + n0 + (lane & 31)]);
#pragma unroll
    for (int i = 0; i < 32; ++i) scr[(2 * i + (lane >> 5)) * 33 + (lane & 31)] = tv[i];
    LDS_WAIT(); asm volatile("" ::: "memory");
    const int c = lane & 7;
#pragma unroll
    for (int j = 0; j < 4; ++j) { const int n = (lane >> 3) + 8 * j; const LAS float* s = scr + (8 * c) * 33 + n;
        v4u o; o.x = pk2c(s[0 * 33], s[1 * 33]); o.y = pk2c(s[2 * 33], s[3 * 33]); o.z = pk2c(s[4 * 33], s[5 * 33]); o.w = pk2c(s[6 * 33], s[7 * 33]);
        *(GAS v4u*)(WT + (size_t)(n0 + n) * K + k0 + 8 * c) = o; }
    LDS_WAIT(); asm volatile("" ::: "memory");
}
__device__ __forceinline__ void rms_row_to_bf16(int lane, const float* xrow, const float* w, bf16* orow) {
    const GAS f32x4* xr = (const GAS f32x4*)xrow + lane;
    f32x4 v[8]; float s = 0.f;
#pragma unroll
    for (int j = 0; j < 8; ++j) { v[j] = xr[64 * j]; s += (v[j].x * v[j].x + v[j].y * v[j].y) + (v[j].z * v[j].z + v[j].w * v[j].w); }
    const float rstd = 1.0f / sqrtf(wave_sum(s) * (1.f / DMODEL) + 1e-6f);
    const GAS f32x4* wr = (const GAS f32x4*)w + lane;
    GAS v2u* o8 = (GAS v2u*)orow + lane;
#pragma unroll
    for (int j = 0; j < 8; ++j) { const f32x4 wv = wr[64 * j]; v2u o; o.x = pk2c(v[j].x * rstd * wv.x, v[j].y * rstd * wv.y); o.y = pk2c(v[j].z * rstd * wv.z, v[j].w * rstd * wv.w); o8[64 * j] = o; }
}
__device__ __forceinline__ void sincos_d(double x, double& s, double& c) {
    const double TWO_PI = 6.283185307179586476925286766559;
    const double k = __builtin_rint(x / TWO_PI); const double r = x - k * TWO_PI, r2 = r * r;
    double ts = r, tc = 1.0; s = r; c = 1.0;
    for (int n = 1; n <= 14; ++n) { tc *= -r2 / (double)((2 * n - 1) * (2 * n)); ts *= -r2 / (double)((2 * n) * (2 * n + 1)); c += tc; s += ts; }
}
__device__ __forceinline__ void rms_2rows_to_bf16(int lane, const float* x0, const float* x1, const float* w, bf16* o0, bf16* o1, float* inv2) {
    const GAS f32x4* xr0 = (const GAS f32x4*)x0 + lane; const GAS f32x4* xr1 = (const GAS f32x4*)x1 + lane;
    f32x4 v0[8], v1[8]; float s0 = 0.f, s1 = 0.f;
#pragma unroll
    for (int j = 0; j < 8; ++j) { v0[j] = __builtin_nontemporal_load(&xr0[64 * j]); v1[j] = __builtin_nontemporal_load(&xr1[64 * j]); }
#pragma unroll
    for (int j = 0; j < 8; ++j) { s0 += (v0[j].x * v0[j].x + v0[j].y * v0[j].y) + (v0[j].z * v0[j].z + v0[j].w * v0[j].w); s1 += (v1[j].x * v1[j].x + v1[j].y * v1[j].y) + (v1[j].z * v1[j].z + v1[j].w * v1[j].w); }
    const float i0 = sqrtf(wave_sum(s0) * (1.f / DMODEL) + 1e-6f), i1 = sqrtf(wave_sum(s1) * (1.f / DMODEL) + 1e-6f); const float r0 = 1.0f / i0, r1 = 1.0f / i1;
    if (lane == 0) *(f32x2*)inv2 = (f32x2){i0, i1};
    const GAS f32x4* wr = (const GAS f32x4*)w + lane;
    GAS v2u* p0 = (GAS v2u*)o0 + lane; GAS v2u* p1 = (GAS v2u*)o1 + lane;
#pragma unroll
    for (int j = 0; j < 8; ++j) { const f32x4 wv = wr[64 * j];
        p0[64 * j] = (v2u){pk2c(v0[j].x * r0 * wv.x, v0[j].y * r0 * wv.y), pk2c(v0[j].z * r0 * wv.z, v0[j].w * r0 * wv.w)};
        p1[64 * j] = (v2u){pk2c(v1[j].x * r1 * wv.x, v1[j].y * r1 * wv.y), pk2c(v1[j].z * r1 * wv.z, v1[j].w * r1 * wv.w)}; }
}
__device__ __forceinline__ void p0_prologue(Frame& F) {
    if (F.wave < 4) {
        const int aw = F.vcu * 4 + F.wave, NAW = F.G * 4;
        for (int m = 2 * aw; m < T_TOK; m += 2 * NAW) rms_2rows_to_bf16(F.lane, F.x + (size_t)m * DMODEL, F.x + (size_t)(m + 1) * DMODEL, F.norm1_w, F.H1 + (size_t)m * DMODEL, F.H1 + (size_t)(m + 1) * DMODEL, F.INVR + m);
        return;
    }
    LAS float* scr = (LAS float*)(F.lds + F.wave * 16384);
    const int gw = F.vcu * 4 + (F.wave - 4), NGW = F.G * 4;
    const int gtid = gw * 64 + F.lane, NT = NGW * 64;
    constexpr int I_IN = (2048 / 64) * (5248 / 32), I_OUT = (2048 / 64) * (2048 / 32);
    for (int it = gw; it < I_IN + I_OUT; it += NGW) {
        if (it < I_IN) p0_transpose_item(F.w_in, 2048, 5248, F.WinT, scr, it, F.lane);
        else p0_transpose_item(F.w_out, 2048, 2048, F.WoutT, scr, it - I_IN, F.lane);
    }
    for (int i = gtid; i < 128 * 2048 / 8; i += NT) ((GAS v4u*)(F.WinT + (size_t)5248 * 2048))[i] = (v4u){0u, 0u, 0u, 0u};
    for (int i = gtid; i < 4 * 96 * 1024; i += NT) { const int c = i & 1023, ml = i >> 10, mat = ml / 96, l = ml - mat * 96;
        const float v = (mat < 2 ? F.w2 : F.a2)[(size_t)((mat & 1) * 96 + l) * 1024 + c];
        F.w2T[(size_t)(((mat * 32 + (c >> 5)) * 6 + (l >> 4)) * 512) + ((((l >> 3) & 1) * 32 + (c & 31)) * 8) + (l & 7)] = (bf16)f2bf(v); }
    for (int i = gtid; i < 256 * 1024; i += NT) { const int c = i & 1023, l = i >> 10;
        F.g2T[(size_t)((((c >> 5) * 16 + (l >> 4)) * 512)) + ((((l >> 3) & 1) * 32 + (c & 31)) * 8) + (l & 7)] = (bf16)f2bf(F.g2[i]); }
    for (int i = gtid; i < 1024; i += NT) { double s, c; sincos_d((double)(i >> 4) * kRopeInv[i & 15], s, c); F.ROPE[2 * i] = (float)c; F.ROPE[2 * i + 1] = (float)s; }
    for (int tile = gw; tile < 4096; tile += NGW) {
        const int hp = tile >> 8, nt = (tile >> 6) & 3, dt = tile & 63, c32 = F.lane & 31, hi = F.lane >> 5;
        const GAS f32x4* ka = (const GAS f32x4*)(F.sub_keys + (size_t)(hp * 128 + nt * 32 + c32) * 128 + hi * 8);
        const GAS f32x4* wb = (const GAS f32x4*)(F.w_pq + (size_t)(dt * 32 + c32) * 2048 + hp * 128 + hi * 8);
        f32x16 acc;
#pragma unroll
        for (int r = 0; r < 16; ++r) acc[r] = 0.f;
#pragma unroll 1
        for (int kh = 0; kh < 2; ++kh) {
            f32x4 av[8], bv[8];
#pragma unroll
            for (int ks = 0; ks < 4; ++ks) { av[2 * ks] = ka[16 * kh + 4 * ks]; av[2 * ks + 1] = ka[16 * kh + 4 * ks + 1]; bv[2 * ks] = wb[16 * kh + 4 * ks]; bv[2 * ks + 1] = wb[16 * kh + 4 * ks + 1]; }
#pragma unroll
            for (int ks = 0; ks < 4; ++ks) {
                const f32x4 a0 = av[2 * ks], a1 = av[2 * ks + 1], b0 = bv[2 * ks], b1 = bv[2 * ks + 1];
                const v4u ah = (v4u){pk2c(a0.x, a0.y), pk2c(a0.z, a0.w), pk2c(a1.x, a1.y), pk2c(a1.z, a1.w)}, bh = (v4u){pk2c(b0.x, b0.y), pk2c(b0.z, b0.w), pk2c(b1.x, b1.y), pk2c(b1.z, b1.w)};
                const v4u al = (v4u){pk2c(a0.x - bflo(ah.x), a0.y - bfhi(ah.x)), pk2c(a0.z - bflo(ah.y), a0.w - bfhi(ah.y)), pk2c(a1.x - bflo(ah.z), a1.y - bfhi(ah.z)), pk2c(a1.z - bflo(ah.w), a1.w - bfhi(ah.w))};
                const v4u bl = (v4u){pk2c(b0.x - bflo(bh.x), b0.y - bfhi(bh.x)), pk2c(b0.z - bflo(bh.y), b0.w - bfhi(bh.y)), pk2c(b1.x - bflo(bh.z), b1.y - bfhi(bh.z)), pk2c(b1.z - bflo(bh.w), b1.w - bfhi(bh.w))};
                acc = __builtin_amdgcn_mfma_f32_32x32x16_bf16(__builtin_bit_cast(bf16x8, ah), __builtin_bit_cast(bf16x8, bh), acc, 0, 0, 0);
                acc = __builtin_amdgcn_mfma_f32_32x32x16_bf16(__builtin_bit_cast(bf16x8, ah), __builtin_bit_cast(bf16x8, bl), acc, 0, 0, 0);
                acc = __builtin_amdgcn_mfma_f32_32x32x16_bf16(__builtin_bit_cast(bf16x8, al), __builtin_bit_cast(bf16x8, bh), acc, 0, 0, 0);
            }
        }
        bf16* op = F.WsT + (size_t)(hp * 128 + nt * 32 + 4 * hi) * 2048 + dt * 32 + c32;
        const float w2d = F.norm2_w[dt * 32 + c32];
#pragma unroll
        for (int r = 0; r < 16; ++r) op[(size_t)((r & 3) + 8 * (r >> 2)) * 2048] = (bf16)pk2c(acc[r] * w2d, 0.f);
    }
}

__device__ __forceinline__ float shifted(const bf16* P, size_t row, int t, int col, float mp, float mn) {
    const bf16* p = P + row * PC + col;
    const float z = bf2f(p[0]);
    const float zp = (t > 0) ? bf2f(*(p - PC)) : 0.f;
    const float zn = (t < SEQL - 1) ? bf2f(p[PC]) : 0.f;
    return z + mp * (zp - z) + mn * (zn - z);
}

template <bool QKPREP> __device__ __forceinline__ void p2_prep(Frame& F) {
    LAS bf16* At = (LAS bf16*)F.lds;
    LAS bf16* Raw = (LAS bf16*)(F.lds + 41472);
    const int lane = F.lane, wave = F.wave, c32 = lane & 31, hi = lane >> 5;
    bf16* EW = F.H;
    for (int u = blockIdx.x; u < T_TOK / 32; u += F.G) {
        const int row0 = u * 32;
        for (int i = 0; i < 6; ++i) { const int item = F.tid + 512 * i;
            if (item < 34 * 80) { const int rr = item / 80, seg = item - rr * 80; const int row = row0 - 1 + rr;
                const bool ok = !((rr == 0 && (row0 & (SEQL - 1)) == 0) || (rr == 33 && ((row0 + 32) & (SEQL - 1)) == 0));
                v4u v = (v4u){0u, 0u, 0u, 0u};
                if (ok) v = __builtin_nontemporal_load((const GAS v4u*)(F.P + (size_t)row * PC + COL_LORA + seg * 8));
                *(LAS v4u*)(Raw + rr * 640 + seg * 8) = v; } }
        __syncthreads();
        for (int i = 0; i < 5; ++i) { const int item = F.tid + 512 * i, tok = item / 80, seg = item - tok * 80;
            const v4u z4 = *(const LAS v4u*)(Raw + (tok + 1) * 640 + seg * 8), p4 = *(const LAS v4u*)(Raw + tok * 640 + seg * 8), n4 = *(const LAS v4u*)(Raw + (tok + 2) * 640 + seg * 8);
            const f32x4 mpa = *(const f32x4*)(F.mu_prev + COL_LORA + seg * 8), mpb = *(const f32x4*)(F.mu_prev + COL_LORA + seg * 8 + 4), mna = *(const f32x4*)(F.mu_next + COL_LORA + seg * 8), mnb = *(const f32x4*)(F.mu_next + COL_LORA + seg * 8 + 4);
            float a[8];
#pragma unroll
            for (int j = 0; j < 8; ++j) { const unsigned zw = z4[j >> 1], pw = p4[j >> 1], nw = n4[j >> 1];
                const float z = (j & 1) ? bfhi(zw) : bflo(zw), zp = (j & 1) ? bfhi(pw) : bflo(pw), zn = (j & 1) ? bfhi(nw) : bflo(nw);
                const float mp = j < 4 ? mpa[j & 3] : mpb[j & 3], mn = j < 4 ? mna[j & 3] : mnb[j & 3];
                const float zs = z + mp * (zp - z) + mn * (zn - z);
                a[j] = seg < 24 ? tanh_f(zs) : (seg < 48 ? zs : sigmoid_f(zs)); }
            *(LAS v4u*)(At + tok * 648 + seg * 8) = (v4u){pk2c(a[0], a[1]), pk2c(a[2], a[3]), pk2c(a[4], a[5]), pk2c(a[6], a[7])}; }
        __syncthreads();
        LAS unsigned char* Ot = F.lds + 41472 + wave * 8704;
#define P2_WLOAD96(wf, b_) do { const bf16* wp_ = F.w2T + (size_t)((((b_) >> 2) * 32 + wave * 4 + ((b_) & 3)) * 6) * 512 + lane * 8; \
            _Pragma("unroll") for (int ks = 0; ks < 6; ++ks) wf[ks] = *(const bf16x8*)(wp_ + ks * 512); } while (0)
#define P2_MMA96(wf, acc, b_) do { _Pragma("unroll") for (int r = 0; r < 16; ++r) acc[r] = 0.f; \
            const LAS bf16* ap = At + c32 * 648 + ((b_) >> 2) * 96 + hi * 8; \
            _Pragma("unroll") for (int ks = 0; ks < 6; ++ks) acc = __builtin_amdgcn_mfma_f32_32x32x16_bf16(wf[ks], *(const LAS bf16x8*)(ap + ks * 16), acc, 0, 0, 0); } while (0)
#define P2_BIAS96(bvv, b_) do { const int mat = (b_) >> 2, ch0 = wave * 128 + ((b_) & 3) * 32 + 4 * hi; const float* bp = (mat < 2 ? F.w0 + mat * 1024 : F.a0 + (mat - 2) * 1024) + ch0; \
            _Pragma("unroll") for (int r4 = 0; r4 < 4; ++r4) bvv[r4] = *(const f32x4*)(bp + 8 * r4); } while (0)
#define P2_EPI96(acc, bvv, b_) do { const int mat = (b_) >> 2; const float sc = mat < 2 ? 0.6065306597126334f : 1.0f; \
            LAS unsigned char* tp = Ot + c32 * 272 + ((b_) & 3) * 64 + 8 * hi; \
            _Pragma("unroll") for (int r4 = 0; r4 < 4; ++r4) { const f32x4 bv = bvv[r4]; \
                const float o0 = sc * sigmoid_f(acc[4 * r4] + bv.x), o1 = sc * sigmoid_f(acc[4 * r4 + 1] + bv.y), o2 = sc * sigmoid_f(acc[4 * r4 + 2] + bv.z), o3 = sc * sigmoid_f(acc[4 * r4 + 3] + bv.w); \
                *(LAS v2u*)(tp + 16 * r4) = (v2u){pk2c(o0, o1), pk2c(o2, o3)}; } \
            if (((b_) & 3) == 3) { LDS_WAIT(); bf16* dp = (mat < 2 ? EW + (size_t)mat * T_TOK * 1024 : F.AR + (size_t)(mat - 2) * T_TOK * 1024) + (size_t)row0 * 1024 + wave * 128 + (lane & 15) * 8; \
                _Pragma("unroll") for (int i8 = 0; i8 < 8; ++i8) { const int rw_ = (lane >> 4) + 4 * i8; *(GAS v4u*)(dp + (size_t)rw_ * 1024) = *(const LAS v4u*)(Ot + rw_ * 272 + (lane & 15) * 16); } \
                LDS_WAIT(); } } while (0)
        { bf16x8 wa[6], wb[6]; f32x16 acc; f32x4 bvv[4];
          P2_WLOAD96(wa, 0); P2_WLOAD96(wb, 1);
#pragma unroll 1
          for (int b = 0; b < 16; b += 2) {
              P2_BIAS96(bvv, b); asm volatile("" ::: "memory"); P2_MMA96(wa, acc, b); asm volatile("" : "+v"(acc)); if (b + 2 < 16) P2_WLOAD96(wa, b + 2); asm volatile("" ::: "memory"); P2_EPI96(acc, bvv, b);
              P2_BIAS96(bvv, b + 1); asm volatile("" ::: "memory"); P2_MMA96(wb, acc, b + 1); asm volatile("" : "+v"(acc)); if (b + 3 < 16) P2_WLOAD96(wb, b + 3); asm volatile("" ::: "memory"); P2_EPI96(acc, bvv, b + 1); } }
#undef P2_BIAS96
#undef P2_WLOAD96
#undef P2_MMA96
#undef P2_EPI96
#define P2_WLOADG(wf, cb_) do { const bf16* wp_ = F.g2T + (size_t)((wave * 4 + (cb_)) * 16) * 512 + lane * 8; \
            _Pragma("unroll") for (int ks = 0; ks < 16; ++ks) wf[ks] = *(const bf16x8*)(wp_ + ks * 512); } while (0)
        { bf16x8 ga[16]; f32x16 acc;
          P2_WLOADG(ga, 0);
#pragma unroll 1
          for (int cb = 0; cb < 4; ++cb) {
#pragma unroll
              for (int r = 0; r < 16; ++r) acc[r] = 0.f;
              const LAS bf16* ap = At + c32 * 648 + 384 + hi * 8;
#pragma unroll
              for (int ks = 0; ks < 16; ++ks) acc = __builtin_amdgcn_mfma_f32_32x32x16_bf16(ga[ks], *(const LAS bf16x8*)(ap + ks * 16), acc, 0, 0, 0);
              asm volatile("" : "+v"(acc));
              if (cb + 1 < 4) P2_WLOADG(ga, cb + 1);
              { LAS unsigned char* tp = Ot + c32 * 272 + cb * 64 + 8 * hi;
#pragma unroll
                for (int r4 = 0; r4 < 4; ++r4) *(LAS v2u*)(tp + 16 * r4) = (v2u){pk2c(acc[4 * r4], acc[4 * r4 + 1]), pk2c(acc[4 * r4 + 2], acc[4 * r4 + 3])}; }
              if (cb == 3) { LDS_WAIT(); bf16* dp = F.G16 + (size_t)row0 * 1024 + wave * 128 + (lane & 15) * 8;
#pragma unroll
                for (int i8 = 0; i8 < 8; ++i8) { const int rw_ = (lane >> 4) + 4 * i8; *(GAS v4u*)(dp + (size_t)rw_ * 1024) = *(const LAS v4u*)(Ot + rw_ * 272 + (lane & 15) * 16); }
                LDS_WAIT(); } } }
#undef P2_WLOADG
        if (QKPREP) for (int ib = 0; ib < 4; ++ib) {
            const int li = lane & 15;
            bf16* pp[5]; v2u xw[5]; f32x4 cs0[5], cs1[5]; int hq[5];
#pragma unroll
            for (int u5 = 0; u5 < 5; ++u5) { const int it4 = wave + NWAVES * (5 * ib + u5);
                const int item = it4 * 4 + (lane >> 4), tok = item / 20, hh = item - tok * 20;
                const size_t row = (size_t)(row0 + tok); const int t = (int)(row & (SEQL - 1));
                pp[u5] = F.P + row * PC + (hh < 16 ? COL_Q + hh * 64 : COL_KA + (hh - 16) * 64) + 4 * li; hq[u5] = hh;
                xw[u5] = *(const GAS v2u*)pp[u5];
                const int pos = (li < 8) ? (t >> 6) : (t & 63);
                cs0[u5] = *(const f32x4*)(F.ROPE + 2 * (pos * 16 + 4 * (li & 3))); cs1[u5] = *(const f32x4*)(F.ROPE + 2 * (pos * 16 + 4 * (li & 3)) + 4); }
            const f32x4 wq = *(const f32x4*)(F.qnw + 4 * li), wk = *(const f32x4*)(F.knw + 4 * li);
            v2u ow[5];
#pragma unroll
            for (int u5 = 0; u5 < 5; ++u5) {
                const f32x4 xv = (f32x4){bflo(xw[u5].x), bfhi(xw[u5].x), bflo(xw[u5].y), bfhi(xw[u5].y)};
                const float ss = allred16((xv.x * xv.x + xv.y * xv.y) + (xv.z * xv.z + xv.w * xv.w));
                const float rstd = __builtin_amdgcn_rsqf(ss * (1.f / 64.f) + 1e-6f);
                const f32x4 xn = xv * rstd * (hq[u5] < 16 ? wq : wk);
                f32x4 pr;
#pragma unroll
                for (int j = 0; j < 4; ++j) { const float up = dppf<0x104>(xn[j]), dn = dppf<0x114>(xn[j]); pr[j] = (li & 4) ? dn : up; }
                const f32x4 cc = (f32x4){cs0[u5].x, cs0[u5].z, cs1[u5].x, cs1[u5].z}, sn = (f32x4){cs0[u5].y, cs0[u5].w, cs1[u5].y, cs1[u5].w};
                f32x4 o = (li & 4) ? (xn * cc + pr * sn) : (xn * cc - pr * sn);
                if (hq[u5] < 16) o = o * attn_body::C2;
                ow[u5] = (v2u){pk2c(o.x, o.y), pk2c(o.z, o.w)}; }
#pragma unroll
            for (int u5 = 0; u5 < 5; ++u5) *(GAS v2u*)pp[u5] = ow[u5];
        }
        __syncthreads();
    }
}

__device__ __forceinline__ bf16x8 pack4z(f32x4 v) { const unsigned a = pk2c(v.x, v.y), b = pk2c(v.z, v.w); const v4u w = (v4u){a, b, 0u, 0u}; return __builtin_bit_cast(bf16x8, w); }
__device__ __forceinline__ bf16x8 ld8z(const LAS unsigned char* p) { const v2u a = *(const LAS v2u*)p; const v4u w = (v4u){a.x, a.y, 0u, 0u}; return __builtin_bit_cast(bf16x8, w); }
__device__ __forceinline__ bf16x8 ld16(const LAS unsigned char* p) { return *(const LAS bf16x8*)p; }
typedef short s16x4_t __attribute__((ext_vector_type(4)));
__device__ __forceinline__ void glds16s_nt(const void* gsrc, unsigned lds_dst) { unsigned keep;
    asm volatile("s_mov_b32 %0, m0\n\ts_mov_b32 m0, %2\n\ts_nop 0\n\tglobal_load_lds_dwordx4 %1, off nt\n\ts_mov_b32 m0, %0" : "=&s"(keep) : "v"(gsrc), "s"(lds_dst) : "memory"); }
__device__ __forceinline__ void glds16s(const void* gsrc, unsigned lds_dst) { unsigned keep;
    asm volatile("s_mov_b32 %0, m0\n\ts_mov_b32 m0, %2\n\ts_nop 0\n\tglobal_load_lds_dwordx4 %1, off\n\ts_mov_b32 m0, %0" : "=&s"(keep) : "v"(gsrc), "s"(lds_dst) : "memory"); }
__device__ __forceinline__ v2u vtr2(const LAS unsigned char* p) { return __builtin_bit_cast(v2u, __builtin_amdgcn_ds_read_tr16_b64_v4i16((LAS s16x4_t*)p)); }
__device__ __forceinline__ void tab_load(const Frame& F, int r, int lane, f32x4 (&v)[8]) {
    const int tb = r >> 14, row = r & 16383;
    const GAS f32x4* src = (const GAS f32x4*)((tb ? F.v_tab : F.u_tab) + (size_t)row * 2048) + lane;
#pragma unroll
    for (int j = 0; j < 8; ++j) v[j] = __builtin_nontemporal_load(&src[64 * j]);
}
__device__ __forceinline__ void tab_finish(const Frame& F, int r, int lane, const f32x4 (&v)[8]) {
    const int tb = r >> 14, row = r & 16383;
    float am = 0.f;
#pragma unroll
    for (int j = 0; j < 8; ++j) am = fmaxf(fmaxf(am, fmaxf(fabsf(v[j].x), fabsf(v[j].y))), fmaxf(fabsf(v[j].z), fabsf(v[j].w)));
    am = wave_max(am);
    const unsigned ab = __float_as_uint(am * (1.0f / 7.5f));
    const float sc = am > 0.f ? __uint_as_float((ab + 0x7FFFFFu) & 0x7F800000u) : 1.0f;
    f32x16 x, y;
#pragma unroll
    for (int j = 0; j < 8; ++j) { x[2 * j] = v[j].x; y[2 * j] = v[j].y; x[2 * j + 1] = v[j].z; y[2 * j + 1] = v[j].w; }
    const v6u p = __builtin_amdgcn_cvt_scalef32_2xpk16_fp6_f32(x, y, sc);
    unsigned char* drow = (tb ? F.V8 : F.U8) + (size_t)row * 1536;
    __builtin_nontemporal_store((v4u){p[0], p[1], p[2], p[3]}, (GAS v4u*)(drow + lane * 16)); __builtin_nontemporal_store((v2u){p[4], p[5]}, (GAS v2u*)(drow + 1024 + lane * 8));
    if (lane == 0) (tb ? F.VS : F.US)[row] = sc;
}
struct Conv2C { f32x2 mp_r, mn_r, mp_k, mn_k, mp_v, mn_v, kkw, kaw; };
template <int PAIRIDX> __device__ __forceinline__ void scan_convert2(const LAS unsigned char* rawp, LAS unsigned char* Mn, int dir, int lane, const Conv2C& K) {
    constexpr int CS = 16, S0 = 2 * PAIRIDX;
    const int half = lane >> 5, cp = lane & 31, s = S0 + half;
    const LAS unsigned* rw = (const LAS unsigned*)rawp + cp;
    unsigned pe[S0 > 0 ? S0 : 1];
#pragma unroll
    for (int sp = 0; sp < S0; ++sp) { const int rr0 = dir ? (CS - sp) : (sp + 1); pe[sp] = rw[(54 + rr0 - 1) * 32]; }
    const int rr = dir ? (CS - s) : (s + 1);
    const int rrE = dir ? (CS - S0) : (S0 + 1);
    const unsigned r0w = rw[rr * 32], rpw = rw[(rr - 1) * 32], rnw = rw[(rr + 1) * 32];
    const unsigned k0w = rw[(18 + rr) * 32], kpw = rw[(18 + rr - 1) * 32], knw = rw[(18 + rr + 1) * 32];
    const unsigned v0w = rw[(36 + rr) * 32], vpw = rw[(36 + rr - 1) * 32], vnw = rw[(36 + rr + 1) * 32];
    const unsigned eww = rw[(54 + rr - 1) * 32], eEw = rw[(54 + rrE - 1) * 32], aaw = rw[(70 + rr - 1) * 32];
    float cum0 = 0.f, cum1 = 0.f;
#pragma unroll
    for (int sp = 0; sp < S0; ++sp) { cum0 += bflo(pe[sp]); cum1 += bfhi(pe[sp]); }
    if (half) { cum0 += bflo(eEw); cum1 += bfhi(eEw); }
    const f32x2 r0 = {bflo(r0w), bfhi(r0w)}, rp = {bflo(rpw), bfhi(rpw)}, rn = {bflo(rnw), bfhi(rnw)};
    const f32x2 k0 = {bflo(k0w), bfhi(k0w)}, kp = {bflo(kpw), bfhi(kpw)}, kn = {bflo(knw), bfhi(knw)};
    const f32x2 v0 = {bflo(v0w), bfhi(v0w)}, vp = {bflo(vpw), bfhi(vpw)}, vn = {bflo(vnw), bfhi(vnw)};
    const f32x2 rs = r0 + K.mp_r * (rp - r0) + K.mn_r * (rn - r0), kx = k0 + K.mp_k * (kp - k0) + K.mn_k * (kn - k0), vv = v0 + K.mp_v * (vp - v0) + K.mn_v * (vn - v0);
    const f32x2 kkr = kx * K.kkw;
    float n2 = kkr.x * kkr.x + kkr.y * kkr.y;
    n2 = allred16(n2);
    { const auto r16 = __builtin_amdgcn_permlane16_swap(__float_as_uint(n2), __float_as_uint(n2), false, false); n2 = __uint_as_float(r16[0]) + __uint_as_float(r16[1]); }
    const float rn2 = __builtin_amdgcn_rsqf(fmaxf(n2, 1e-24f));
    const f32x2 kk = kkr * rn2, ew = {bflo(eww), bfhi(eww)}, aa = {bflo(aaw), bfhi(aaw)};
    const f32x2 cA = {cum0, cum1}, cB = cA + ew;
    f32x2 Lp, Lt, Li; Lp.x = __expf(-cA.x); Lp.y = __expf(-cA.y); Lt.x = __expf(-cB.x); Lt.y = __expf(-cB.y); Li.x = __expf(cB.x); Li.y = __expf(cB.y);
    const f32x2 av = Lp * kk, bv = kk * aa * Li, cv = kx * ((aa - 1.0f) * K.kaw + 1.0f) * Li, qv = rs * Lt;
    const unsigned aw_ = pk2c(av.x, av.y), bw_ = pk2c(bv.x, bv.y), cw_ = pk2c(cv.x, cv.y), qw_ = pk2c(qv.x, qv.y), vw_ = pk2c(vv.x, vv.y);
    LAS unsigned* m32 = (LAS unsigned*)Mn + cp;
    m32[0 * 576 + s * 36] = aw_; m32[1 * 576 + s * 36] = bw_; m32[2 * 576 + s * 36] = cw_; m32[3 * 576 + s * 36] = qw_;
    m32[4 * 576 + s * 36] = vw_;
    if (s == CS - 1) *(LAS f32x2*)((LAS float*)(Mn + 11520) + 2 * cp) = Lt;
}
__device__ __forceinline__ void p3_scan(Frame& F) {
    constexpr int CS = 16, NC = SEQL / CS;
    constexpr int MP = 144;
    constexpr int PAR = 11776;
    constexpr int O_SB = 3 * PAR;
    constexpr int O_SM = O_SB + 9216;
    constexpr int O_NF = O_SM + 4096;
    constexpr int O_YB = O_NF + 1024;
    constexpr int O_RAW = O_YB + 8192;
    constexpr int RAWB = (3 * 18 + 16 + 16) * 128;
    static_assert(O_RAW + 4 * RAWB <= 131072, "scan LDS");
    LAS unsigned char* L = F.lds;
    const int lane = F.lane, w = F.wave, g = lane >> 4, c = lane & 15, tid = F.tid;
    for (int chain = blockIdx.x; chain < 256; chain += F.G) {
        const int dir = chain >> 7, b = (chain >> 4) & 7, h = chain & 15;
        const int ch = h * 64 + lane;
        const float mp_r = F.mu_prev[ch], mn_r = F.mu_next[ch], mp_k = F.mu_prev[1024 + ch], mn_k = F.mu_next[1024 + ch], mp_v = F.mu_prev[2048 + ch], mn_v = F.mu_next[2048 + ch];
        const float kkw = F.k_k[ch], kaw = F.k_a[ch];
        Conv2C K2; { const int c2 = h * 64 + 2 * (lane & 31);
            K2.mp_r = *(const f32x2*)(F.mu_prev + c2); K2.mn_r = *(const f32x2*)(F.mu_next + c2); K2.mp_k = *(const f32x2*)(F.mu_prev + 1024 + c2); K2.mn_k = *(const f32x2*)(F.mu_next + 1024 + c2);
            K2.mp_v = *(const f32x2*)(F.mu_prev + 2048 + c2); K2.mn_v = *(const f32x2*)(F.mu_next + 2048 + c2); K2.kkw = *(const f32x2*)(F.k_k + c2); K2.kaw = *(const f32x2*)(F.k_a + c2); }
        const bf16* EWd = F.H + (size_t)dir * T_TOK * 1024 + (size_t)b * SEQL * 1024 + h * 64;
        const bf16* ARd = F.AR + (size_t)dir * T_TOK * 1024 + (size_t)b * SEQL * 1024 + h * 64;
        const bf16* Pb = F.P + (size_t)b * SEQL * PC + h * 64;
        const bf16* l_ptr[2]; int l_t[2]; int l_step[2]; bool l_on[2], l_chk[2]; unsigned l_dst[2];
#pragma unroll
        for (int sl = 0; sl < 2; ++sl) { const int item = sl == 0 ? tid : ((lane < 22) ? 512 + 22 * w + lane : 1 << 20); const int tlo0 = dir ? (SEQL - CS) : 0;
            l_dst[sl] = (unsigned)item * 16u;
            if (item < 432) { const int arr = item / 144, rem = item - arr * 144, rr = rem >> 3, seg = rem & 7; l_on[sl] = true; l_chk[sl] = true; l_t[sl] = tlo0 - 1 + rr;
                l_ptr[sl] = Pb + (ptrdiff_t)(tlo0 - 1 + rr) * PC + arr * 1024 + seg * 8; l_step[sl] = (dir ? -CS : CS) * PC; }
            else if (item < 688) { const int k2 = item >= 560, rem = item - (k2 ? 560 : 432), rr = rem >> 3, seg = rem & 7; l_on[sl] = true; l_chk[sl] = false; l_t[sl] = 0;
                l_ptr[sl] = (k2 ? ARd : EWd) + (ptrdiff_t)(tlo0 + rr) * 1024 + seg * 8; l_step[sl] = (dir ? -CS : CS) * 1024; }
            else { l_on[sl] = false; l_chk[sl] = false; l_t[sl] = 0; l_ptr[sl] = Pb; l_step[sl] = 0; } }
        const unsigned dma0 = (unsigned)(size_t)(L + O_RAW) + (unsigned)(w * 64) * 16u, dma1 = (unsigned)(size_t)(L + O_RAW) + (unsigned)(512 + 22 * w) * 16u;
        f32x4 st[4]; st[0] = (f32x4){0.f, 0.f, 0.f, 0.f}; st[1] = st[0]; st[2] = st[0]; st[3] = st[0];
        __syncthreads();
        for (int i = tid; i < 9216 / 4; i += 512) ((LAS unsigned*)(L + O_SB))[i] = 0u;
        for (int ci = -4; ci < NC; ++ci) {
            LAS unsigned char* M = L + ((ci + 6) % 3) * PAR;
            LAS unsigned char* SMc = L + O_SM + (ci & 1) * 2048;
            v2u yv = (v2u){0u, 0u}; GAS v2u* yp = nullptr;
            if (ci >= 1 && tid < 256) { const LAS float* yb = (const LAS float*)(L + O_YB + ((ci - 1) & 1) * 4096); const int s = tid >> 4, i4 = (tid & 15) * 4; const int stp = (ci - 1) * CS + s; const int t = dir ? (SEQL - 1 - stp) : stp;
                const f32x4 yf = *(const LAS f32x4*)(yb + s * 64 + i4); yv = (v2u){pk2c(yf.x, yf.y), pk2c(yf.z, yf.w)}; yp = (GAS v2u*)((bf16*)F.Y + ((size_t)dir * T_TOK + (size_t)b * SEQL + t) * 1024 + h * 64 + i4);
                *yp = yv; }
            const int cl = ci + 4; const bool doload = cl < NC;
            if (doload) { const unsigned stg = (unsigned)((cl & 3) * RAWB);
#pragma unroll
                for (int sl = 0; sl < 2; ++sl) {
                    if (l_on[sl]) {
                        if (!l_chk[sl] || (unsigned)l_t[sl] < (unsigned)SEQL) { if (sl) glds16s_nt(l_ptr[sl], dma1 + stg); else glds16s(l_ptr[sl], dma0 + stg); }
                        else *(LAS v4u*)(L + O_RAW + stg + l_dst[sl]) = (v4u){0u, 0u, 0u, 0u}; }
                    l_ptr[sl] += l_step[sl]; l_t[sl] += dir ? -CS : CS; } }
            if (w >= 4) {
                if (ci >= 0) {
                    const int n = w - 4;
                    const LAS float* Lc = (const LAS float*)(M + 11520);
                    const LAS unsigned char* trb = M + (4 * g + (c >> 2)) * MP + (c & 3) * 8;
                    v2u bB[4], bC[4]; f32x4 lc[4];
#pragma unroll
                    for (int jt = 0; jt < 4; ++jt) { bB[jt] = vtr2(trb + 1 * 2304 + 32 * jt); bC[jt] = vtr2(trb + 2 * 2304 + 32 * jt); lc[jt] = *(const LAS f32x4*)(Lc + 16 * jt + 4 * g); }
                    const v2u vtw = vtr2(trb + 4 * 2304 + 32 * n);
                    f32x4 g1t = (f32x4){0.f, 0.f, 0.f, 0.f}, qst = g1t;
                    const LAS unsigned char* Sb = L + O_SB + (16 * n + c) * MP + 16 * g;
#pragma unroll
                    for (int ks = 0; ks < 2; ++ks) { const bf16x8 sv = ld16(Sb + 64 * ks);
                        g1t = __builtin_amdgcn_mfma_f32_16x16x32_bf16(ld16(M + 0 * 2304 + c * MP + 16 * g + 64 * ks), sv, g1t, 0, 0, 0);
                        qst = __builtin_amdgcn_mfma_f32_16x16x32_bf16(ld16(M + 3 * 2304 + c * MP + 16 * g + 64 * ks), sv, qst, 0, 0, 0); }
                    const bf16x8 vt = __builtin_bit_cast(bf16x8, (v4u){vtw.x, vtw.y, 0u, 0u});
                    const f32x4 w1t = __builtin_amdgcn_mfma_f32_16x16x32_bf16(ld8z(SMc + 0 + c * 32 + g * 8), vt, g1t, 0, 0, 0);
                    const f32x4 ut = __builtin_amdgcn_mfma_f32_16x16x32_bf16(ld8z(SMc + 1536 + c * 32 + g * 8), pack4z(w1t), (f32x4){0.f, 0.f, 0.f, 0.f}, 0, 0, 0);
                    f32x4 yt = __builtin_amdgcn_mfma_f32_16x16x32_bf16(ld8z(SMc + 512 + c * 32 + g * 8), pack4z(ut), qst, 0, 0, 0);
                    yt = __builtin_amdgcn_mfma_f32_16x16x32_bf16(ld8z(SMc + 1024 + c * 32 + g * 8), vt, yt, 0, 0, 0);
                    LAS float* yb = (LAS float*)(L + O_YB + (ci & 1) * 4096);
#pragma unroll
                    for (int r = 0; r < 4; ++r) yb[(4 * g + r) * 64 + 16 * n + c] = yt[r];
                    const bf16x8 av = __builtin_bit_cast(bf16x8, (v4u){pk2c(ut.x, ut.y), pk2c(ut.z, ut.w), vtw.x, vtw.y});
#pragma unroll
                    for (int jt = 0; jt < 4; ++jt) {
                        f32x4 ns = __builtin_amdgcn_mfma_f32_16x16x32_bf16(__builtin_bit_cast(bf16x8, (v4u){bB[jt].x, bB[jt].y, bC[jt].x, bC[jt].y}), av, st[jt], 0, 0, 0);
                        ns = ns * lc[jt]; st[jt] = ns;
                        *(LAS v2u*)(L + O_SB + (16 * n + c) * MP + (16 * jt + 4 * g) * 2) = (v2u){pk2c(ns.x, ns.y), pk2c(ns.z, ns.w)}; }
                }
            } else if (ci + 1 >= 0 && ci + 1 < NC) {
                const LAS unsigned char* Mg = L + ((ci + 4) % 3) * PAR;
                LAS unsigned char* SMn = L + O_SM + ((ci + 1) & 1) * 2048;
                const LAS unsigned char* Lm = Mg + ((w & 1) ? 2 : 1) * 2304;
                const LAS unsigned char* Rm = Mg + ((w & 2) ? 3 : 0) * 2304;
                f32x4 x = (f32x4){0.f, 0.f, 0.f, 0.f};
#pragma unroll
                for (int ks = 0; ks < 2; ++ks) x = __builtin_amdgcn_mfma_f32_16x16x32_bf16(ld16(Lm + c * MP + 16 * g + 64 * ks), ld16(Rm + c * MP + 16 * g + 64 * ks), x, 0, 0, 0);
#pragma unroll
                for (int r = 0; r < 4; ++r) { const int tau = 4 * g + r; const bool keep = (w < 2) ? (tau < c) : (tau <= c); x[r] = keep ? x[r] : 0.f; }
                if (w == 0) {
#if SCAN_INV_MFMA
#define MM(Z, Y) __builtin_amdgcn_mfma_f32_16x16x32_bf16(pack4z(Z), pack4z(Y), (f32x4){0.f, 0.f, 0.f, 0.f}, 0, 0, 0)
                    f32x4 nt = (f32x4){0.f, 0.f, 0.f, 0.f};
#pragma unroll
                    for (int ks = 0; ks < 2; ++ks) nt = __builtin_amdgcn_mfma_f32_16x16x32_bf16(ld16(Rm + c * MP + 16 * g + 64 * ks), ld16(Lm + c * MP + 16 * g + 64 * ks), nt, 0, 0, 0);
                    f32x4 id;
#pragma unroll
                    for (int r = 0; r < 4; ++r) { nt[r] = (c < 4 * g + r) ? nt[r] : 0.f; id[r] = (4 * g + r == c) ? 1.f : 0.f; }
                    const f32x4 n2 = MM(nt, x), n2t = MM(x, nt);
                    const f32x4 n4 = MM(n2t, n2), n4t = MM(n2, n2t);
                    const f32x4 n8 = MM(n4t, n4);
                    const f32x4 t1t = MM(id + n2, id - nt);
                    const f32x4 t2t = MM(id + n4, t1t);
                    const f32x4 inv = MM(t2t, id + n8);
#undef MM
                    *(LAS v2u*)(SMn + 1536 + c * 32 + g * 8) = (v2u){pk2c(-inv.x, -inv.y), pk2c(-inv.z, -inv.w)};
#else
                    LAS float* Nf = (LAS float*)(L + O_NF);
#pragma unroll
                    for (int r = 0; r < 4; ++r) Nf[(4 * g + r) * 16 + c] = x[r];
                    LDS_WAIT();
                    float nrow[16][16];
#pragma unroll
                    for (int t = 0; t < 15; ++t) {
#pragma unroll
                        for (int q4 = 0; q4 < 4; ++q4) { const f32x4 nv = *(const LAS f32x4*)(Nf + t * 16 + 4 * q4); nrow[t][4 * q4] = nv.x; nrow[t][4 * q4 + 1] = nv.y; nrow[t][4 * q4 + 2] = nv.z; nrow[t][4 * q4 + 3] = nv.w; } }
                    float xr[16];
#pragma unroll
                    for (int t = 0; t < 16; ++t) xr[t] = (c == t) ? 1.f : 0.f;
#pragma unroll
                    for (int t = 0; t < 15; ++t) {
#pragma unroll
                        for (int t2 = t + 1; t2 < 16; ++t2) xr[t2] -= xr[t] * nrow[t][t2];
                    }
                    LAS bf16* InvT = (LAS bf16*)(SMn + 1536);
                    if (lane < 16) {
#pragma unroll
                        for (int t = 0; t < 16; ++t) InvT[t * 16 + c] = (bf16)pk2c(-xr[t], 0.f);
                    }
#endif
                } else {
                    LAS unsigned char* XT = SMn + (w - 1) * 512;
                    *(LAS v2u*)(XT + c * 32 + g * 8) = (v2u){pk2c(x.x, x.y), pk2c(x.z, x.w)};
                }
            }
            if (ci + 2 >= 0 && ci + 2 < NC) {
                const int cc = ci + 2;
                const LAS unsigned char* rwp = L + O_RAW + (cc & 3) * RAWB;
                LAS unsigned char* Mn = L + ((ci + 5) % 3) * PAR;
                switch (w) { case 0: scan_convert2<0>(rwp, Mn, dir, lane, K2); break; case 1: scan_convert2<1>(rwp, Mn, dir, lane, K2); break; case 2: scan_convert2<2>(rwp, Mn, dir, lane, K2); break; case 3: scan_convert2<3>(rwp, Mn, dir, lane, K2); break;
                             case 4: scan_convert2<4>(rwp, Mn, dir, lane, K2); break; case 5: scan_convert2<5>(rwp, Mn, dir, lane, K2); break; case 6: scan_convert2<6>(rwp, Mn, dir, lane, K2); break; default: scan_convert2<7>(rwp, Mn, dir, lane, K2); break; }
            }
            asm volatile("" :: "v"(yv), "v"(yp));
            if (doload) asm volatile("s_waitcnt vmcnt(2)" ::: "memory");
            else asm volatile("s_waitcnt vmcnt(0)" ::: "memory");
            __syncthreads();
        }
        if (tid < 256) { const LAS float* yb = (const LAS float*)(L + O_YB + ((NC - 1) & 1) * 4096); const int s = tid >> 4, i4 = (tid & 15) * 4; const int stp = (NC - 1) * CS + s; const int t = dir ? (SEQL - 1 - stp) : stp;
            const f32x4 yf = *(const LAS f32x4*)(yb + s * 64 + i4);
            *(GAS v2u*)((bf16*)F.Y + ((size_t)dir * T_TOK + (size_t)b * SEQL + t) * 1024 + h * 64 + i4) = (v2u){pk2c(yf.x, yf.y), pk2c(yf.z, yf.w)}; }
    }
}

__device__ __forceinline__ f32x4 shifted4(const bf16* P, size_t row, int t, int col, f32x4 mp, f32x4 mn) {
    const bf16* p = P + row * PC + col;
    const v2u z2 = *(const GAS v2u*)p; v2u zp2 = (v2u){0u, 0u}, zn2 = (v2u){0u, 0u};
    if (t > 0) zp2 = *(const GAS v2u*)(p - PC);
    if (t < SEQL - 1) zn2 = *(const GAS v2u*)(p + PC);
    const f32x4 z = (f32x4){bflo(z2.x), bfhi(z2.x), bflo(z2.y), bfhi(z2.y)}, zp = (f32x4){bflo(zp2.x), bfhi(zp2.x), bflo(zp2.y), bfhi(zp2.y)}, zn = (f32x4){bflo(zn2.x), bfhi(zn2.x), bflo(zn2.y), bfhi(zn2.y)};
    return z + mp * (zp - z) + mn * (zn - z);
}
struct CRow { v2u yf, yb, af, ab, g, r0, rp, rn, k0, kp, kn, v0, vp, vn; };
__device__ __forceinline__ void combine_load(CRow& R, const Frame& F, int rowi, int c0) {
    const size_t row = (size_t)rowi; const int t = rowi & (SEQL - 1); const bool hp = t > 0, hn = t < SEQL - 1;
    R.yf = __builtin_nontemporal_load((const GAS v2u*)((const bf16*)F.Y + row * 1024 + c0)); R.yb = __builtin_nontemporal_load((const GAS v2u*)((const bf16*)F.Y + ((size_t)T_TOK + row) * 1024 + c0));
    R.af = __builtin_nontemporal_load((const GAS v2u*)(F.AR + row * 1024 + c0)); R.ab = __builtin_nontemporal_load((const GAS v2u*)(F.AR + ((size_t)T_TOK + row) * 1024 + c0)); R.g = __builtin_nontemporal_load((const GAS v2u*)(F.G16 + row * 1024 + c0));
    const bf16* p = F.P + row * PC + c0; const v2u z = (v2u){0u, 0u};
    R.r0 = *(const GAS v2u*)(p + COL_R); R.rp = hp ? *(const GAS v2u*)(p + COL_R - PC) : z; R.rn = hn ? *(const GAS v2u*)(p + COL_R + PC) : z;
    R.k0 = *(const GAS v2u*)(p + COL_K); R.kp = hp ? *(const GAS v2u*)(p + COL_K - PC) : z; R.kn = hn ? *(const GAS v2u*)(p + COL_K + PC) : z;
    R.v0 = *(const GAS v2u*)(p + COL_V); R.vp = hp ? *(const GAS v2u*)(p + COL_V - PC) : z; R.vn = hn ? *(const GAS v2u*)(p + COL_V + PC) : z;
}
__device__ __forceinline__ f32x4 up4(v2u w) { return (f32x4){bflo(w.x), bfhi(w.x), bflo(w.y), bfhi(w.y)}; }
__device__ __forceinline__ v2u combine_row(const CRow& R, f32x4 mp_r, f32x4 mn_r, f32x4 mp_k, f32x4 mn_k, f32x4 mp_v, f32x4 mn_v, f32x4 kaw, f32x4 rkw, f32x4 lw, f32x4 lb) {
    const f32x4 y = up4(R.yf) + up4(R.yb);
    const f32x4 r0 = up4(R.r0), k0 = up4(R.k0), v0 = up4(R.v0);
    const f32x4 r = r0 + mp_r * (up4(R.rp) - r0) + mn_r * (up4(R.rn) - r0), k = k0 + mp_k * (up4(R.kp) - k0) + mn_k * (up4(R.kn) - k0), v = v0 + mp_v * (up4(R.vp) - v0) + mn_v * (up4(R.vn) - v0);
    const float mu = allred16((y.x + y.y) + (y.z + y.w)) * (1.f / 64.f);
    const f32x4 d = y - mu;
    const float var = allred16((d.x * d.x + d.y * d.y) + (d.z * d.z + d.w * d.w)) * (1.f / 64.f);
    const f32x4 yn = d * __builtin_amdgcn_rsqf(var + 64e-5f) * lw + lb;
    const f32x4 am = (up4(R.af) + up4(R.ab)) * 0.5f;
    const f32x4 km = k * ((am - 1.0f) * kaw + 1.0f);
    const f32x4 pr = r * km * rkw;
    const float bs = allred16((pr.x + pr.y) + (pr.z + pr.w));
    const f32x4 o = (yn + v * bs) * up4(R.g);
    return (v2u){pk2c(o.x, o.y), pk2c(o.z, o.w)};
}
__device__ __forceinline__ void p5_combine(Frame& F) {
    const int gw = F.vcu * NWAVES + F.wave, NGW = F.G * NWAVES, lane = F.lane;
    bf16* MIX = F.H;
    const int q = gw & 3, c0 = q * 256 + lane * 4;
    const f32x4 mp_r = *(const f32x4*)(F.mu_prev + c0), mn_r = *(const f32x4*)(F.mu_next + c0), mp_k = *(const f32x4*)(F.mu_prev + 1024 + c0), mn_k = *(const f32x4*)(F.mu_next + 1024 + c0),
                mp_v = *(const f32x4*)(F.mu_prev + 2048 + c0), mn_v = *(const f32x4*)(F.mu_next + 2048 + c0), kaw = *(const f32x4*)(F.k_a + c0), rkw = *(const f32x4*)(F.r_k + c0),
                lw = *(const f32x4*)(F.lnx_w + c0), lb = *(const f32x4*)(F.lnx_b + c0);
    const int stride = NGW >> 2;
    for (int rowi = gw >> 2; rowi < T_TOK; rowi += 4 * stride) {
        CRow R[4]; int rw4[4]; bool ok4[4];
#pragma unroll
        for (int u = 0; u < 4; ++u) { rw4[u] = rowi + u * stride; ok4[u] = rw4[u] < T_TOK; combine_load(R[u], F, ok4[u] ? rw4[u] : rowi, c0); }
        v2u o4[4];
#pragma unroll
        for (int u = 0; u < 4; ++u) o4[u] = combine_row(R[u], mp_r, mn_r, mp_k, mn_k, mp_v, mn_v, kaw, rkw, lw, lb);
#pragma unroll
        for (int u = 0; u < 4; ++u) if (ok4[u]) *(GAS v2u*)(MIX + (size_t)rw4[u] * 2048 + c0) = o4[u];
    }
}

__device__ __forceinline__ unsigned max32(const unsigned (&k)[32]) {
    unsigned m[8];
#pragma unroll
    for (int i = 0; i < 8; ++i) m[i] = umax(umax(k[4 * i], k[4 * i + 1]), umax(k[4 * i + 2], k[4 * i + 3]));
    return umax(umax(umax(m[0], m[1]), umax(m[2], m[3])), umax(umax(m[4], m[5]), umax(m[6], m[7])));
}
__device__ __forceinline__ void p9_peer(Frame& F) {
    const int gw = F.vcu * NWAVES + F.wave, NGW = F.G * NWAVES, lane = F.lane;
    LAS unsigned* sel = (LAS unsigned*)(F.lds + F.wave * 4096);
    LAS unsigned* elist = sel + 256;
    LAS float* glist = (LAS float*)(sel + 384);
    LAS float* alist = (LAS float*)(sel + 512);
    const float* S = F.S;
    unsigned pab[7];
#pragma unroll
    for (int i = 0; i < 7; ++i) pab[i] = kStair[(lane & 7) * 7 + i];
    for (int tok = gw; tok < T_TOK; tok += NGW) {
      float o[32], h2f[32]; float inv_rstd2 = 0.f;
#pragma unroll
      for (int i = 0; i < 32; ++i) o[i] = 0.f;
      for (int rep = 0; rep < NREP(8); ++rep) {
        unsigned key[32], top[16];
        { const int g4 = lane >> 2, q4 = lane & 3;
          typedef _Float16 h8 __attribute__((ext_vector_type(8)));
          const GAS h8* sp = (const GAS h8*)((const _Float16*)S + (size_t)tok * 2048 + g4 * 128 + q4 * 32);
#pragma unroll
          for (int i = 0; i < 4; ++i) { const h8 v = __builtin_nontemporal_load(&sp[i]);
#pragma unroll
              for (int j = 0; j < 8; ++j) key[8 * i + j] = (f2sort((float)v[j]) & 0xFFFFFF80u) | (unsigned)(q4 * 32 + 8 * i + j); }
#pragma unroll
          for (int r = 0; r < 16; ++r) {
              unsigned m = max32(key);
              m = umax(m, dppu<0xB1>(m)); m = umax(m, dppu<0x4E>(m));
              top[r] = m;
#pragma unroll
              for (int i = 0; i < 32; ++i) key[i] = (key[i] == m) ? 0u : key[i];
          }
          if (q4 == 0) {
#pragma unroll
              for (int r = 0; r < 16; r += 4) *(LAS v4u*)(sel + g4 * 16 + r) = (v4u){top[r], top[r + 1], top[r + 2], top[r + 3]};
          }
        }
        LDS_WAIT();
        { const int hd = lane >> 3, q8 = lane & 7;
          const LAS unsigned* s1p = sel + (2 * hd) * 16; const LAS unsigned* s2p = sel + (2 * hd + 1) * 16;
          unsigned k7[7];
#pragma unroll
          for (int i = 0; i < 7; ++i) { const unsigned ab = pab[i]; const float sv = sort2f(s1p[(ab >> 4) & 15u] & 0xFFFFFF80u) + sort2f(s2p[ab & 15u] & 0xFFFFFF80u);
              k7[i] = (ab != 0xFFu) ? ((f2sort(sv) & 0xFFFFFF00u) | ab) : 0u; }
#pragma unroll
          for (int r = 0; r < 16; ++r) {
              unsigned m = umax(umax(umax(k7[0], k7[1]), umax(k7[2], k7[3])), umax(umax(k7[4], k7[5]), k7[6]));
              m = umax(m, dppu<0xB1>(m)); m = umax(m, dppu<0x4E>(m)); m = umax(m, dppu<0x141>(m));
              top[r] = m;
#pragma unroll
              for (int i = 0; i < 7; ++i) k7[i] = (k7[i] == m) ? 0u : k7[i];
          }
          const float v0 = sort2f(top[0] & 0xFFFFFF00u);
#pragma unroll
          for (int r = 0; r < 16; ++r) if (q8 == (r & 7)) { const unsigned ci = top[r] & 0xFFu; const unsigned e1 = s1p[ci >> 4] & 0x7Fu, e2 = s2p[ci & 15u] & 0x7Fu;
              elist[hd * 16 + r] = e1 * 128u + e2; glist[hd * 16 + r] = sort2f(top[r] & 0xFFFFFF00u) - v0; }
        }
        LDS_WAIT();
        { const GAS v2u* xr = (const GAS v2u*)((const bf16*)F.Y + (size_t)tok * DMODEL) + lane; v2u xw[8]; f32x4 xv[8]; float ss = 0.f;
#pragma unroll
          for (int m = 0; m < 8; ++m) xw[m] = __builtin_nontemporal_load(&xr[64 * m]);
#pragma unroll
          for (int m = 0; m < 8; ++m) xv[m] = (f32x4){bflo(xw[m].x), bfhi(xw[m].x), bflo(xw[m].y), bfhi(xw[m].y)};
#pragma unroll
          for (int i = 0; i < 8; ++i) ss += (xv[i].x * xv[i].x + xv[i].y * xv[i].y) + (xv[i].z * xv[i].z + xv[i].w * xv[i].w);
          inv_rstd2 = sqrtf(wave_sum(ss) * (1.f / DMODEL) + 1e-6f); const float rstd = 1.0f / inv_rstd2;
          const GAS f32x4* wr = (const GAS f32x4*)F.norm2_w + lane;
#pragma unroll
          for (int m = 0; m < 8; ++m) { const f32x4 wv = wr[64 * m]; const f32x4 a = xv[m];
              h2f[4 * m + 0] = a.x * rstd * wv.x; h2f[4 * m + 1] = a.y * rstd * wv.y; h2f[4 * m + 2] = a.z * rstd * wv.z; h2f[4 * m + 3] = a.w * rstd * wv.w; }
          const float g0 = __expf(glist[lane] * rstd), g1 = __expf(glist[64 + lane] * rstd);
          const float z0 = allred16(g0), z1 = allred16(g1);
          glist[lane] = g0 / z0; glist[64 + lane] = g1 / z1;
        }
        LDS_WAIT();
        for (int k0 = 0; k0 < 128; k0 += 8) {
            v4u ua[8]; v2u ub[8]; float usc[8];
#pragma unroll
            for (int j = 0; j < 8; ++j) { const unsigned e = (unsigned)__builtin_amdgcn_readfirstlane((int)elist[k0 + j]); const unsigned char* up = F.U8 + (size_t)e * 1536;
                ua[j] = *(const GAS v4u*)(up + lane * 16); ub[j] = *(const GAS v2u*)(up + 1024 + lane * 8); usc[j] = F.US[e]; }
            float dd[8];
#pragma unroll
            for (int j = 0; j < 8; ++j) { const f32x32 uf = __builtin_amdgcn_cvt_scalef32_pk32_f32_fp6((v6u){ua[j].x, ua[j].y, ua[j].z, ua[j].w, ub[j].x, ub[j].y}, usc[j]);
                f32x2 da = (f32x2){0.f, 0.f}, db = da;
#pragma unroll
                for (int m = 0; m < 8; ++m) { da = __builtin_elementwise_fma((f32x2){uf[4 * m], uf[4 * m + 1]}, (f32x2){h2f[4 * m], h2f[4 * m + 1]}, da);
                                              db = __builtin_elementwise_fma((f32x2){uf[4 * m + 2], uf[4 * m + 3]}, (f32x2){h2f[4 * m + 2], h2f[4 * m + 3]}, db); }
                dd[j] = (da.x + da.y) + (db.x + db.y); }
            float e4[4], f2[2];
#pragma unroll
            for (int j = 0; j < 4; ++j) { const auto rr = __builtin_amdgcn_permlane32_swap(__float_as_uint(dd[j]), __float_as_uint(dd[j + 4]), false, false); e4[j] = __uint_as_float(rr[0]) + __uint_as_float(rr[1]); }
#pragma unroll
            for (int j = 0; j < 2; ++j) { const auto rr = __builtin_amdgcn_permlane16_swap(__float_as_uint(e4[j]), __float_as_uint(e4[j + 2]), false, false); f2[j] = __uint_as_float(rr[0]) + __uint_as_float(rr[1]); }
            allred16x2(f2[0], f2[1]);
            { const int q = lane >> 4, i0 = k0 + 2 * (q & 1) + 4 * (q >> 1);
              const float a0 = gelu_f(f2[0]) * glist[i0], a1 = gelu_f(f2[1]) * glist[i0 + 1];
              if ((lane & 15) == 0) { alist[i0] = a0; alist[i0 + 1] = a1; } }
        }
        LDS_WAIT();
        for (int k0 = 0; k0 < 128; k0 += PEER_RIF) {
            v4u va[PEER_RIF]; v2u vb[PEER_RIF]; float ac[PEER_RIF], vsc[PEER_RIF];
#pragma unroll
            for (int j = 0; j < PEER_RIF; ++j) { const unsigned e = (unsigned)__builtin_amdgcn_readfirstlane((int)elist[k0 + j]); const unsigned char* vp = F.V8 + (size_t)e * 1536;
                va[j] = *(const GAS v4u*)(vp + lane * 16); vb[j] = *(const GAS v2u*)(vp + 1024 + lane * 8); ac[j] = alist[k0 + j]; vsc[j] = F.VS[e]; }
#pragma unroll
            for (int j = 0; j < PEER_RIF; ++j) { const f32x32 vf = __builtin_amdgcn_cvt_scalef32_pk32_f32_fp6((v6u){va[j].x, va[j].y, va[j].z, va[j].w, vb[j].x, vb[j].y}, vsc[j]); const float a = ac[j];
#pragma unroll
                for (int m = 0; m < 32; ++m) o[m] += a * vf[m]; }
        }
      }
      if (NREP(8) > 1) {
#pragma unroll
          for (int i = 0; i < 32; ++i) o[i] *= (1.0f / NREP(8));
      }
        { GAS f32x4* xr = (GAS f32x4*)(F.out + (size_t)tok * DMODEL) + lane; float ss = 0.f;
          { const GAS f32x4* w2r = (const GAS f32x4*)F.norm2_w + lane;
#pragma unroll
            for (int m = 0; m < 8; ++m) { const f32x4 w2 = w2r[64 * m];
                o[4 * m + 0] += h2f[4 * m + 0] * inv_rstd2 * __builtin_amdgcn_rcpf(w2.x); o[4 * m + 1] += h2f[4 * m + 1] * inv_rstd2 * __builtin_amdgcn_rcpf(w2.y);
                o[4 * m + 2] += h2f[4 * m + 2] * inv_rstd2 * __builtin_amdgcn_rcpf(w2.z); o[4 * m + 3] += h2f[4 * m + 3] * inv_rstd2 * __builtin_amdgcn_rcpf(w2.w); } }
#pragma unroll
          for (int i = 0; i < 32; ++i) ss += o[i] * o[i];
          const float rstd = 1.0f / sqrtf(wave_sum(ss) * (1.f / DMODEL) + 1e-6f);
          const GAS f32x4* wr = (const GAS f32x4*)F.normf_w + lane;
#pragma unroll
          for (int m = 0; m < 8; ++m) { const f32x4 wv = wr[64 * m];
              __builtin_nontemporal_store((f32x4){o[4 * m + 0] * rstd * wv.x, o[4 * m + 1] * rstd * wv.y, o[4 * m + 2] * rstd * wv.z, o[4 * m + 3] * rstd * wv.w}, &xr[64 * m]); }
        }
        LDS_WAIT();
    }
}

struct Args { const float* in[24]; float* out; unsigned char* ws; int ph_lo, ph_hi, li, pad; };
__global__ void __launch_bounds__(NWAVES * 64, 2) hybrid_fwd(Args args) {
    extern __shared__ __attribute__((aligned(16))) unsigned char lds[];
    Frame F;
    F.lds = (LAS unsigned char*)lds;
    F.MISC = (volatile LAS unsigned*)(F.lds + MISC_OFF);
    F.tid = threadIdx.x; F.lane = F.tid & 63; F.wave = __builtin_amdgcn_readfirstlane(F.tid >> 6);
    F.G = gridDim.x; { const int bx = blockIdx.x; F.vcu = (F.G % 8 == 0) ? (bx % 8) * (F.G / 8) + bx / 8 : bx; }
    unsigned char* ws = args.ws;
    F.ctl = (gu32*)(ws + WS_CTL);
    F.x = args.in[0]; F.w_in = args.in[1]; F.mu_prev = args.in[2]; F.mu_next = args.in[3]; F.w0 = args.in[4]; F.w2 = args.in[5]; F.a0 = args.in[6]; F.a2 = args.in[7]; F.g2 = args.in[8];
    F.k_k = args.in[9]; F.k_a = args.in[10]; F.r_k = args.in[11]; F.lnx_w = args.in[12]; F.lnx_b = args.in[13]; F.qnw = args.in[14]; F.knw = args.in[15]; F.w_out = args.in[16];
    F.norm1_w = args.in[17]; F.norm2_w = args.in[18]; F.w_pq = args.in[19]; F.sub_keys = args.in[20]; F.u_tab = args.in[21]; F.v_tab = args.in[22]; F.normf_w = args.in[23];
    F.out = args.out;
    F.ROPE = (float*)(ws + WS_ROPE);
    F.H1 = (bf16*)args.out; F.INVR = (float*)(ws + WS_ROPE + 512 * 1024);
    F.WinT = (bf16*)(ws + WS_WINT); F.WoutT = (bf16*)(ws + WS_WOUTT); F.WsT = (bf16*)(ws + WS_WST);
    F.w2T = (bf16*)(ws + WS_LORA); F.a2T = F.w2T + 2 * 1024 * 96; F.g2T = F.a2T + 2 * 1024 * 96;
    F.H = (bf16*)(ws + WS_H); F.P = (bf16*)(ws + WS_P); F.AR = (bf16*)(ws + WS_AR); F.G16 = (bf16*)(ws + WS_G); F.Y = (float*)(ws + WS_Y);
    F.U16 = (bf16*)(ws + WS_P); F.V16 = F.U16 + (size_t)16384 * 2048;
    F.U8 = ws + WS_TAB; F.V8 = F.U8 + (size_t)16384 * 2048; F.US = (float*)(F.V8 + (size_t)16384 * 2048); F.VS = F.US + 16384;
    F.S = (float*)(ws + WS_P);
    for (int u = F.tid; u < (LDS_BYTES - LDSCTL_OFF) / 4; u += NWAVES * 64) ((LAS unsigned*)(F.lds + LDSCTL_OFF))[u] = 0u;
    __syncthreads();
    const int lo = args.ph_lo, hi = args.ph_hi;
    const bool multi = (hi - lo) > 1;
    XcdBarrier bar; bar.bar = (unsigned*)(F.ctl + CW_BAR); bar.x = 0; bar.st = nullptr;
    if (multi) bar = xcd_barrier_post((unsigned*)(F.ctl + CW_BAR), F.MISC + 8);
#define IN(k) (lo <= (k) && (k) < hi)
#define SEAM(k) do { if (IN(k) && IN((k) + 1)) xcd_barrier(bar); } while (0)

    if (IN(0)) { for (int rep = 0; rep < NREP(0); ++rep) p0_prologue(F); SEAM(0); }
    if (IN(1)) {
        pg8::Gemm g{F.H1, F.WinT, T_TOK, PC, DMODEL}; pg8::StaticOrder S; S.init(T_TOK, PC, F.G, (int)blockIdx.x);
        pg8::EpiBf16<0> E{F.P, PC, nullptr, 0, 0, 1.f};
        for (int rep = 0; rep < NREP(1); ++rep) pg8::gemm_phase<pg8::EpiBf16<0>, pg8::StaticOrder, true, true>(F.lds, g, S, E);
        { const int nwg = (T_TOK / 256) * (PC / 256), rem = nwg % F.G; const int first = rem, nidle = rem ? F.G - rem : F.G;
          const int bx = (int)blockIdx.x;
          if (bx >= (rem ? first : 0)) {
              const int iw = (bx - (rem ? first : 0)) * NWAVES + F.wave, NIW = nidle * NWAVES;
              for (int r0 = 2 * iw; r0 < 32768; r0 += 2 * NIW) { f32x4 ta[8], tb[8]; tab_load(F, r0, F.lane, ta); tab_load(F, r0 + 1, F.lane, tb); tab_finish(F, r0, F.lane, ta); tab_finish(F, r0 + 1, F.lane, tb); }
          } }
        SEAM(1);
    }
    if (IN(2)) { for (int rep = 1; rep < NREP(2); ++rep) p2_prep<false>(F); p2_prep<true>(F); SEAM(2); }
    if (IN(3)) { for (int rep = 0; rep < NREP(3); ++rep) p3_scan(F); SEAM(3); }
    if (IN(4)) {
        const attn_body::AttnTensors AT{(const attn_body::bf16*)(F.P + COL_Q), (const attn_body::bf16*)(F.P + COL_KA), (const attn_body::bf16*)(F.P + COL_VA), (attn_body::bf16*)(F.H + 1024)};
        const attn_body::StaticOrder S((int)F.G, F.vcu);
        for (int rep = 0; rep < NREP(4); ++rep) attn_body::attn_phase<attn_body::StaticOrder>((char*)lds, AT, S);
        for (int rep = 0; rep < NREP(9); ++rep) p5_combine(F);
        SEAM(4);
    }
    if (IN(5)) {
        pg8::Gemm g{F.H, F.WoutT, T_TOK, DMODEL, DMODEL}; pg8::StaticOrder S; S.init(T_TOK, DMODEL, F.G, (int)blockIdx.x);
        pg8::EpiX2 E{DMODEL, (const pg8::bf16_t*)F.H1, F.INVR, F.norm1_w, (pg8::bf16_t*)F.Y};
        for (int rep = 0; rep < NREP(5); ++rep) pg8::gemm_phase<pg8::EpiX2, pg8::StaticOrder, true, true>(F.lds, g, S, E);
        SEAM(5);
    }
    if (IN(7)) {
        pg8::Gemm g{(const bf16*)F.Y, F.WsT, T_TOK, DMODEL, DMODEL}; pg8::StaticOrder S; S.init(T_TOK, DMODEL, F.G, (int)blockIdx.x);
        pg8::EpiF16P E{(_Float16*)F.S, DMODEL};
        for (int rep = 0; rep < NREP(7); ++rep) pg8::gemm_phase<pg8::EpiF16P, pg8::StaticOrder, true, true>(F.lds, g, S, E);
        SEAM(7);
    }
    if (IN(8)) { p9_peer(F); }
#undef IN
#undef SEAM
}

extern "C" void kernel_launch(void* const* d_in, const int* in_sizes, int n_in, void* d_out, int out_size, void* d_ws, size_t ws_size, hipStream_t stream) {
    static int grid = 0;
    if (grid == 0) {
        if (n_in != 24 || out_size != T_TOK * DMODEL || ws_size < WS_END) { fprintf(stderr, "kernel_launch: unexpected shapes (n_in %d, out %d, ws %zu); nothing launched\n", n_in, out_size, ws_size); grid = -1; return; }
        int dev = 0, cus = 0, per_cu = 0;
        if (hipGetDevice(&dev) != hipSuccess || hipDeviceGetAttribute(&cus, hipDeviceAttributeMultiprocessorCount, dev) != hipSuccess) { grid = -1; return; }
        if (hipFuncSetAttribute((const void*)hybrid_fwd, hipFuncAttributeMaxDynamicSharedMemorySize, LDS_BYTES) != hipSuccess) { fprintf(stderr, "kernel_launch: hipFuncSetAttribute failed\n"); grid = -1; return; }
        if (hipOccupancyMaxActiveBlocksPerMultiprocessor(&per_cu, (const void*)hybrid_fwd, NWAVES * 64, LDS_BYTES) != hipSuccess || per_cu < 1) fprintf(stderr, "kernel_launch: occupancy query reports %d\n", per_cu);
        (void)hipGetLastError();
        grid = cus;
    }
    if (grid < 0) return;
    (void)hipMemsetAsync((char*)d_ws + WS_CTL, 0, CTL_ZERO_BYTES, stream);
    Args a{};
    for (int i = 0; i < 24; ++i) a.in[i] = (const float*)d_in[i];
    a.out = (float*)d_out; a.ws = (unsigned char*)d_ws;
#if MK_ONE_LAUNCH
    a.ph_lo = 0; a.ph_hi = N_PHASES; a.li = 0;
    hipLaunchKernelGGL(hybrid_fwd, dim3(grid), dim3(NWAVES * 64), LDS_BYTES, stream, a);
#else
    for (int p = 0; p < N_PHASES; ++p) { a.ph_lo = p; a.ph_hi = p + 1; a.li = p; hipLaunchKernelGGL(hybrid_fwd, dim3(grid), dim3(NWAVES * 64), LDS_BYTES, stream, a); }
#endif
}
```
